# Optimizing an MI355X kernel written in HIP

```python
import jax, jax.numpy as jnp
from jax import lax
import numpy as np

D_MODEL = 1024
BATCH = 8
SEQ = 8192
DEPTH = 1

N_META = 16
BLOCK = 128
WINDOW = 128
HEAD_DIM = 64
ATT_Q_HEADS = D_MODEL // HEAD_DIM
ATT_KV_HEADS = max(ATT_Q_HEADS // 8, 1)
ATT_GROUP = ATT_Q_HEADS // ATT_KV_HEADS
ATT_WIDTH = ATT_Q_HEADS * HEAD_DIM
ATT_KV_WIDTH = ATT_KV_HEADS * HEAD_DIM
ROPE_THETA = 10000.0
RWKV_HEAD = 64
RWKV_HEADS = D_MODEL // RWKV_HEAD
RWKV_WIDTH = RWKV_HEADS * RWKV_HEAD
DECAY_LORA = 64
ICLR_LORA = 64
RWKV_SHIFT_WIDTH = 3 * RWKV_WIDTH + DECAY_LORA + ICLR_LORA
RMS_EPS = 1e-6
GN_EPS = 64e-5
NEG_INF = -1e30
SPLIT_SIZES = (ATT_WIDTH, ATT_KV_WIDTH, ATT_KV_WIDTH, ATT_WIDTH, RWKV_WIDTH, RWKV_WIDTH, RWKV_WIDTH, DECAY_LORA, ICLR_LORA, RWKV_WIDTH, D_MODEL, D_MODEL)
IN_WIDTH = 2 * ATT_WIDTH + 2 * ATT_KV_WIDTH + 4 * RWKV_WIDTH + DECAY_LORA + ICLR_LORA + 2 * D_MODEL

kernel_name = 'hybrid_swa_sink_rwkv7_gated_merge'


def _offsets(sizes):
    out, acc = [], 0
    for s in sizes[:-1]:
        acc += s
        out.append(acc)
    return out


def _rmsnorm(x, w):
    xf = x.astype(jnp.float32)
    y = xf * lax.rsqrt(jnp.mean(xf * xf, axis=-1, keepdims=True) + RMS_EPS)
    return (y * w.astype(jnp.float32)).astype(x.dtype)


def _rope(x, pos):
    half = x.shape[-1] // 2
    inv = 1.0 / (ROPE_THETA ** (jnp.arange(half, dtype=jnp.float32) / half))
    ang = pos[:, None] * inv[None, :]
    cos = jnp.cos(ang)[:, None, :]
    sin = jnp.sin(ang)[:, None, :]
    xf = x.astype(jnp.float32)
    x1, x2 = xf[..., :half], xf[..., half:]
    return jnp.concatenate([x1 * cos - x2 * sin, x2 * cos + x1 * sin], axis=-1).astype(x.dtype)


def _token_shift(z):
    return jnp.pad(z, ((0, 0), (1, 0), (0, 0)))[:, :-1]


def _sliding_window_gqa(q, k, v, sinks):
    B, T = q.shape[0], q.shape[1]
    pad = (-T) % BLOCK
    Tp = T + pad
    nb = Tp // BLOCK
    padw = ((0, 0), (pad, 0), (0, 0), (0, 0))
    q = jnp.pad(q, padw).reshape(B, nb, BLOCK, ATT_KV_HEADS, ATT_GROUP, HEAD_DIM)
    k = jnp.pad(k, padw).reshape(B, nb, BLOCK, ATT_KV_HEADS, HEAD_DIM)
    v = jnp.pad(v, padw).reshape(B, nb, BLOCK, ATT_KV_HEADS, HEAD_DIM)

    def window(t):
        prev = jnp.concatenate([jnp.zeros_like(t[:, :1]), t[:, :-1]], axis=1)
        return jnp.moveaxis(jnp.concatenate([prev, t], axis=2), 1, 0)

    kw, vw = window(k), window(v)
    qm = jnp.moveaxis(q, 1, 0)
    sink = sinks.astype(jnp.float32).reshape(ATT_KV_HEADS, ATT_GROUP)[None, :, :, None, None]
    scale = HEAD_DIM ** -0.5

    def block(args):
        n, qn, kn, vn = args
        s = jnp.einsum('bqhgd,bkhd->bhgqk', qn, kn).astype(jnp.float32) * scale
        qi = n * BLOCK + jnp.arange(BLOCK)
        kj = (n - 1) * BLOCK + jnp.arange(2 * BLOCK)
        diff = qi[:, None] - kj[None, :]
        ok = (diff >= 0) & (diff < WINDOW) & (kj[None, :] >= pad)
        s = jnp.where(ok, s, NEG_INF)
        sb = jnp.broadcast_to(sink, s.shape[:-1] + (1,))
        p = jax.nn.softmax(jnp.concatenate([s, sb], axis=-1), axis=-1)[..., :-1]
        return jnp.einsum('bhgqk,bkhd->bqhgd', p.astype(vn.dtype), vn)

    o = lax.map(block, (jnp.arange(nb), qm, kw, vw))
    o = jnp.moveaxis(o, 0, 1).reshape(B, Tp, ATT_WIDTH)
    return o[:, pad:]


def _rwkv7_time_mix(r, k, v, w_lo, a_lo, mu, w0, w2, a0, a2, k_k, k_a, r_k, ln_w, ln_b):
    f32 = jnp.float32
    B, T = r.shape[0], r.shape[1]
    z = jnp.concatenate([r, k, v, w_lo, a_lo], axis=-1).astype(f32)
    z = z + (_token_shift(z) - z) * mu.astype(f32)
    r, k, v, w_lo, a_lo = jnp.split(z, [RWKV_WIDTH, 2 * RWKV_WIDTH, 3 * RWKV_WIDTH, 3 * RWKV_WIDTH + DECAY_LORA], axis=-1)
    w = -jax.nn.softplus(-(w0.astype(f32) + jnp.tanh(w_lo) @ w2.astype(f32))) - 0.5
    decay = jnp.exp(-jnp.exp(w))
    a = jax.nn.sigmoid(a0.astype(f32) + a_lo @ a2.astype(f32))

    def hs(t):
        return t.reshape(B, T, RWKV_HEADS, RWKV_HEAD)

    kk = hs(k * k_k.astype(f32))
    kk = kk / jnp.maximum(jnp.sqrt(jnp.sum(kk * kk, axis=-1, keepdims=True)), 1e-12)
    k = k * (1.0 + (a - 1.0) * k_a.astype(f32))
    r, k, v, decay, a = hs(r), hs(k), hs(v), hs(decay), hs(a)
    xs = tuple(jnp.moveaxis(t, 1, 0) for t in (r, decay, k, v, -kk, kk * a))

    def step(S, inp):
        r_t, w_t, k_t, v_t, a_t, b_t = inp
        sa = jnp.einsum('bhij,bhj->bhi', S, a_t)
        S = S * w_t[:, :, None, :] + sa[..., None] * b_t[:, :, None, :] + v_t[..., None] * k_t[:, :, None, :]
        return S, jnp.einsum('bhij,bhj->bhi', S, r_t)

    S0 = jnp.zeros((B, RWKV_HEADS, RWKV_HEAD, RWKV_HEAD), f32)
    _, y = lax.scan(step, S0, xs)
    y = jnp.moveaxis(y, 0, 1)
    mean = jnp.mean(y, axis=-1, keepdims=True)
    var = jnp.mean(jnp.square(y - mean), axis=-1, keepdims=True)
    y = ((y - mean) * lax.rsqrt(var + GN_EPS)).reshape(B, T, RWKV_WIDTH) * ln_w.astype(f32) + ln_b.astype(f32)
    bonus = jnp.sum(r * k * r_k.astype(f32), axis=-1, keepdims=True) * v
    return y + bonus.reshape(B, T, RWKV_WIDTH)


def setup_inputs(seed: int = 0) -> dict:
    key = jax.random.key(seed)
    ks = jax.random.split(key, 20)
    f32 = jnp.float32

    def nrm(k, shape, s):
        return jax.random.normal(k, shape, f32) * s

    L = DEPTH
    return {
        'x': nrm(ks[0], (BATCH, SEQ, D_MODEL), 1.0),
        'meta_tokens': nrm(ks[1], (N_META, D_MODEL), 1.0),
        'norm_w': 1.0 + nrm(ks[2], (L, D_MODEL), 0.05),
        'w_in': nrm(ks[3], (L, D_MODEL, IN_WIDTH), D_MODEL ** -0.5),
        'att_sinks': nrm(ks[4], (L, ATT_Q_HEADS), 1.0),
        'rk_mu': jax.random.uniform(ks[5], (L, RWKV_SHIFT_WIDTH), f32, 0.0, 1.0),
        'rk_w0': jax.random.uniform(ks[6], (L, RWKV_WIDTH), f32, -6.0, -1.0),
        'rk_w2': nrm(ks[7], (L, DECAY_LORA, RWKV_WIDTH), 0.1),
        'rk_a0': nrm(ks[8], (L, RWKV_WIDTH), 0.5),
        'rk_a2': nrm(ks[9], (L, ICLR_LORA, RWKV_WIDTH), 0.5 * ICLR_LORA ** -0.5),
        'rk_k_k': 0.85 + nrm(ks[10], (L, RWKV_WIDTH), 0.05),
        'rk_k_a': 1.0 + nrm(ks[11], (L, RWKV_WIDTH), 0.05),
        'rk_r_k': nrm(ks[12], (L, RWKV_HEADS, RWKV_HEAD), 0.1),
        'rk_ln_w': 1.0 + nrm(ks[13], (L, RWKV_WIDTH), 0.05),
        'rk_ln_b': nrm(ks[14], (L, RWKV_WIDTH), 0.01),
        'w_branch_att': nrm(ks[15], (L, ATT_WIDTH, D_MODEL), ATT_WIDTH ** -0.5),
        'w_branch_rwkv': nrm(ks[16], (L, RWKV_WIDTH, D_MODEL), RWKV_WIDTH ** -0.5),
        'w_out': nrm(ks[17], (L, D_MODEL, D_MODEL), D_MODEL ** -0.5),
        'final_norm_w': 1.0 + nrm(ks[18], (D_MODEL,), 0.05),
    }


def reference(x, meta_tokens, norm_w, w_in, att_sinks, rk_mu, rk_w0, rk_w2, rk_a0, rk_a2, rk_k_k, rk_k_a, rk_r_k, rk_ln_w, rk_ln_b, w_branch_att, w_branch_rwkv, w_out, final_norm_w):
    B = x.shape[0]
    meta = jnp.broadcast_to(meta_tokens.astype(x.dtype)[None], (B, N_META, D_MODEL))
    h = jnp.concatenate([meta, x], axis=1)
    T = h.shape[1]
    pos = jnp.arange(T, dtype=jnp.float32)
    split_at = _offsets(SPLIT_SIZES)
    for l in range(DEPTH):
        u = _rmsnorm(h, norm_w[l])
        p = u @ w_in[l].astype(u.dtype)
        q, ka, va, ga, r, kr, vr, wl, al, gr, ma, mr = jnp.split(p, split_at, axis=-1)
        q = _rope(q.reshape(B, T, ATT_Q_HEADS, HEAD_DIM), pos)
        ka = _rope(ka.reshape(B, T, ATT_KV_HEADS, HEAD_DIM), pos)
        va = va.reshape(B, T, ATT_KV_HEADS, HEAD_DIM)
        att = _sliding_window_gqa(q, ka, va, att_sinks[l])
        rw = _rwkv7_time_mix(r, kr, vr, wl, al, rk_mu[l], rk_w0[l], rk_w2[l], rk_a0[l], rk_a2[l], rk_k_k[l], rk_k_a[l], rk_r_k[l], rk_ln_w[l], rk_ln_b[l]).astype(h.dtype)
        ya = (att * jax.nn.silu(ga)) @ w_branch_att[l].astype(h.dtype)
        yr = (rw * jax.nn.silu(gr)) @ w_branch_rwkv[l].astype(h.dtype)
        merged = jax.nn.sigmoid(ma) * ya + jax.nn.sigmoid(mr) * yr
        h = h + merged @ w_out[l].astype(h.dtype)
    y = _rmsnorm(h, final_norm_w)
    return y[:, N_META:]
```

```cpp
#include <hip/hip_runtime.h>
#include <hip/hip_cooperative_groups.h>
#include <cstdio>
#include <cstdint>
namespace cg = cooperative_groups;
#ifndef PHASE_MASK
#define PHASE_MASK 0xFF
#endif

#define LAS __attribute__((address_space(3)))
typedef unsigned short bf16_t;
typedef short bf16x8 __attribute__((ext_vector_type(8)));
typedef short s16x4 __attribute__((ext_vector_type(4)));
typedef float f32x4 __attribute__((ext_vector_type(4)));
typedef float f32x16 __attribute__((ext_vector_type(16)));
typedef unsigned u32x4 __attribute__((ext_vector_type(4)));
typedef unsigned u32x2 __attribute__((ext_vector_type(2)));

constexpr int DM = 1024, NB = 8, SEQ = 8192, NMETA = 16, TT = SEQ + NMETA;
constexpr int MREAL = NB * SEQ;
constexpr int MPAD = MREAL + 256;
constexpr int NIN_SRC = 8576, NIN = 8704;
constexpr int NP1 = 4608;
constexpr float RMS_EPS = 1e-6f, GN_EPS = 64e-5f;
constexpr float LOG2E = 1.4426950408889634f;
constexpr float QSCALE = 0.125f * LOG2E;

constexpr size_t MiB = 1u << 20;
constexpr size_t WS_WIN = 1 * MiB;
constexpr size_t WS_WB = 18 * MiB;
constexpr size_t WS_WOUT = 22 * MiB;
constexpr size_t WS_ROPE = 24 * MiB;
constexpr size_t WS_U = 27 * MiB;
constexpr size_t WS_Q = 156 * MiB;
constexpr size_t WS_KV = 285 * MiB;
constexpr size_t WS_RKV = 318 * MiB;
constexpr size_t WS_WA = 704 * MiB;
constexpr size_t WS_RW = 721 * MiB;
constexpr size_t WS_END = 849 * MiB;

constexpr int LDS_STAGE = 131072;
constexpr int LDS_ROWSS = 131072;
constexpr int LDS_BYTES = 147456;

__device__ __forceinline__ unsigned cvt_pk_bf16(float lo, float hi) { unsigned r; asm volatile("v_cvt_pk_bf16_f32 %0, %1, %2" : "=v"(r) : "v"(lo), "v"(hi)); return r; }
__device__ __forceinline__ float bf2f(unsigned short b) { return __uint_as_float((unsigned)b << 16); }
__device__ __forceinline__ float bflo(unsigned w) { return __uint_as_float(w << 16); }
__device__ __forceinline__ float bfhi(unsigned w) { return __uint_as_float(w & 0xffff0000u); }
__device__ __forceinline__ unsigned short f2bf(float f) { return (unsigned short)(cvt_pk_bf16(f, 0.f) & 0xffffu); }
__device__ __forceinline__ float wave_sum(float v) {
#pragma unroll
    for (int o = 1; o < 64; o <<= 1) v += __shfl_xor(v, o);
    return v;
}
template <int CTRL> __device__ __forceinline__ float dppf(float v) {
    return __builtin_bit_cast(float, __builtin_amdgcn_update_dpp(0, __builtin_bit_cast(int, v), CTRL, 0xF, 0xF, true));
}
__device__ __forceinline__ float red8(float v) {
    v += dppf<0xB1>(v);
    v += dppf<0x4E>(v);
    v += dppf<0x141>(v);
    return v;
}
__device__ __forceinline__ float sigmoidf_(float x) { return __builtin_amdgcn_rcpf(1.f + __builtin_amdgcn_exp2f(-x * LOG2E)); }
__device__ __forceinline__ float siluf_(float x) { return x * sigmoidf_(x); }

namespace pg8 {
constexpr int BM = 256, BK = 64, HALF = 128, HTB = HALF * BK * 2, STAGE_BYTES = 8 * HTB, NXCD = 8, WGM = 8;
__host__ __device__ __forceinline__ int lds_byte(int r, int c) { const int st = (r >> 4) * 2 + (c >> 5), rr = r & 15, cc = c & 31, ob = rr * 64 + cc * 2; return st * 1024 + (ob ^ (((ob >> 9) & 1) << 5)); }
__host__ __device__ __forceinline__ void stage_rc(int b, int& R, int& C) { const int st = b / 1024, sb = b % 1024, swz = sb ^ (((sb >> 9) & 1) << 5); R = (st >> 1) * 16 + swz / 64; C = (st & 1) * 32 + (swz % 64) / 2; }
__host__ __device__ __forceinline__ int perm32(int rho) { const int n = rho >> 4, i = rho & 15; return 8 * (i >> 2) + 4 * n + (i & 3); }

struct Unit { int pm, pn; };
struct Gemm { const bf16_t* A; const bf16_t* A2; const bf16_t* Bt; int K; int asplit; };

struct StaticOrder {
    int nM, nN, nwg, G, c;
    __device__ void init(int M, int N, int G_, int c_) { nM = M / BM; nN = N / BM; nwg = nM * nN; G = G_; c = c_; }
    __device__ bool next(int i, Unit& u) const {
        const long L = (long)i * G + c; if (L >= nwg) return false;
        int wgid = (int)L; { const int q = nwg / NXCD, r = nwg % NXCD, xcd = wgid % NXCD, off = wgid / NXCD; wgid = (xcd < r ? xcd * (q + 1) : r * (q + 1) + (xcd - r) * q) + off; }
        const int nig = WGM * nN, gid = wgid / nig, fm = gid * WGM, gsz = (nM - fm) < WGM ? (nM - fm) : WGM;
        u.pm = fm + ((wgid % nig) % gsz); u.pn = (wgid % nig) / gsz; return true;
    }
};
struct LocalOrder {
    int pm, n;
    __device__ LocalOrder(int pm_, int n_) : pm(pm_), n(n_) { asm volatile("" : "+s"(n)); }
    __device__ bool next(int i, Unit& u) const { if (i >= n) return false; u.pm = pm; u.pn = i; return true; }
};

template <class Epi, class Sched, bool ALIGN_EPI>
__device__ __forceinline__ void gemm_phase(LAS unsigned char* lds, const Gemm g, const Sched& S, const Epi& E) {
    int tid_ = threadIdx.x; asm volatile("" : "+v"(tid_));
    const int tid = tid_, wid = __builtin_amdgcn_readfirstlane(tid >> 6), lane = tid & 63, wr = wid >> 2, wc = wid & 3, fr = lane & 15, fq = lane >> 4;
    const int K = g.K, nt = K / BK;
    unsigned voffA[2], voffB[2];
#pragma unroll
    for (int i = 0; i < 2; ++i) { int R, C; stage_rc(tid * 16 + i * 8192, R, C); const int Rb = Epi::PERM ? ((R & ~31) + perm32(R & 31)) : R;
        voffA[i] = (unsigned)(R * K + C) * 2u; voffB[i] = (unsigned)(Rb * K + C) * 2u; }
    const size_t kstep = (size_t)(BK * 2);
    const size_t hstep = (size_t)HALF * K * 2;
    const size_t tstep = 2 * hstep;
    const unsigned ldsw = (unsigned)wid * 1024u;
    const int aoff = lds_byte(wr * 64 + fr, fq * 8), boff = lds_byte(wc * 32 + fr, fq * 8);
#define PG8_SA(b, h) (((b) * 2 + (h)) * HTB)
#define PG8_SB(b, h) ((4 + (b) * 2 + (h)) * HTB)
#define PG8_STAGE(bufoff, gbase, voff) do { _Pragma("unroll") for (int _i = 0; _i < 2; ++_i) \
        __builtin_amdgcn_global_load_lds((const unsigned*)((const char*)(gbase) + (voff)[_i]), (LAS unsigned*)(lds + (bufoff) + ldsw + _i * 8192), 16, 0, 0); } while (0)
#define PG8_LDA(dst, b, h) do { _Pragma("unroll") for (int m = 0; m < 4; ++m) _Pragma("unroll") for (int k = 0; k < 2; ++k) dst[m][k] = *(const LAS bf16x8*)(lds + PG8_SA(b, h) + aoff + m * 2048 + k * 1024); } while (0)
#define PG8_LDB(dst, b, h) do { _Pragma("unroll") for (int n = 0; n < 2; ++n) _Pragma("unroll") for (int k = 0; k < 2; ++k) dst[n][k] = *(const LAS bf16x8*)(lds + PG8_SB(b, h) + boff + n * 2048 + k * 1024); } while (0)
#define PG8_MMA(ai, bj, At, Bt) do { __builtin_amdgcn_s_setprio(1); _Pragma("unroll") for (int m = 0; m < 4; ++m) _Pragma("unroll") for (int n = 0; n < 2; ++n) _Pragma("unroll") for (int k = 0; k < 2; ++k) \
        acc[ai][bj][m][n] = __builtin_amdgcn_mfma_f32_16x16x32_bf16(Bt[n][k], At[m][k], acc[ai][bj][m][n], 0, 0, 0); __builtin_amdgcn_s_setprio(0); } while (0)
#define PG8_WAIT_V(n) asm volatile("s_waitcnt vmcnt(" #n ")" ::: "memory")
#define PG8_WAIT_L(n) asm volatile("s_waitcnt lgkmcnt(" #n ")" ::: "memory")
#define PG8_BAR __builtin_amdgcn_s_barrier()
#define PG8_SCHED __builtin_amdgcn_sched_barrier(0)
#define PG8_APTR(u) ((const char*)((u).pn >= g.asplit ? g.A2 : g.A) + (size_t)(u).pm * tstep)
#define PG8_BPTR(u) ((const char*)g.Bt + (size_t)(u).pn * tstep)
    Unit cur, nxt; int ui = 0;
    if (!S.next(0, cur)) return;
    f32x4 acc[2][2][4][2];
#pragma unroll
    for (int a = 0; a < 2; ++a)
#pragma unroll
        for (int b = 0; b < 2; ++b)
#pragma unroll
            for (int m = 0; m < 4; ++m)
#pragma unroll
                for (int n = 0; n < 2; ++n) acc[a][b][m][n] = (f32x4){0.f, 0.f, 0.f, 0.f};
    bf16x8 At[4][2], B0[2][2], B1[2][2];
    const char* cA = PG8_APTR(cur); const char* cB = PG8_BPTR(cur);
    PG8_STAGE(PG8_SB(0, 0), cB, voffB); PG8_STAGE(PG8_SB(0, 1), cB + hstep, voffB); PG8_STAGE(PG8_SA(0, 0), cA, voffA); PG8_STAGE(PG8_SA(0, 1), cA + hstep, voffA);
    if (wr == 1) PG8_BAR;
    PG8_WAIT_V(2); PG8_BAR;
    PG8_STAGE(PG8_SB(1, 0), cB + kstep, voffB); PG8_STAGE(PG8_SA(1, 0), cA + kstep, voffA); PG8_STAGE(PG8_SB(1, 1), cB + hstep + kstep, voffB);
    PG8_WAIT_V(6); PG8_BAR;
    for (;;) {
        const bool has_next = S.next(ui + 1, nxt);
        const char* nA = has_next ? PG8_APTR(nxt) : cA; const char* nB = has_next ? PG8_BPTR(nxt) : cB;
        for (int t = 0; t < nt; t += 2) {
            const bool last = (t == nt - 2);
            const char* a1 = cA + (size_t)(t + 1) * kstep;
            const char* a2 = last ? nA : cA + (size_t)(t + 2) * kstep; const char* b2 = last ? nB : cB + (size_t)(t + 2) * kstep;
            const char* a3 = a2 + kstep; const char* b3 = b2 + kstep;
            PG8_LDB(B0, 0, 0); PG8_LDB(B1, 0, 1); PG8_SCHED; PG8_LDA(At, 0, 0); PG8_STAGE(PG8_SA(1, 1), a1 + hstep, voffA);
            PG8_WAIT_V(8); PG8_WAIT_L(0); PG8_BAR; PG8_MMA(0, 0, At, B0); PG8_MMA(0, 1, At, B1); PG8_BAR; PG8_SCHED;
            PG8_LDA(At, 0, 1); PG8_STAGE(PG8_SB(0, 0), b2, voffB); PG8_STAGE(PG8_SB(0, 1), b2 + hstep, voffB); PG8_STAGE(PG8_SA(0, 0), a2, voffA);
            PG8_WAIT_V(8); PG8_WAIT_L(0); PG8_BAR; PG8_MMA(1, 0, At, B0); PG8_MMA(1, 1, At, B1); PG8_BAR; PG8_SCHED;
            PG8_LDB(B0, 1, 0); PG8_LDB(B1, 1, 1); PG8_SCHED; PG8_LDA(At, 1, 0); PG8_STAGE(PG8_SA(0, 1), a2 + hstep, voffA);
            PG8_WAIT_V(8); PG8_WAIT_L(0); PG8_BAR; PG8_MMA(0, 0, At, B0); PG8_MMA(0, 1, At, B1); PG8_BAR; PG8_SCHED;
            PG8_LDA(At, 1, 1); PG8_STAGE(PG8_SB(1, 0), b3, voffB); PG8_STAGE(PG8_SB(1, 1), b3 + hstep, voffB); PG8_STAGE(PG8_SA(1, 0), a3, voffA);
            PG8_WAIT_V(8); PG8_WAIT_L(0); PG8_BAR; PG8_MMA(1, 0, At, B0); PG8_MMA(1, 1, At, B1); PG8_BAR; PG8_SCHED;
        }
        if constexpr (ALIGN_EPI) { if (wr == 0) PG8_BAR; }
        E(acc, cur, wr, wc, fr, fq);
        if (!has_next) break;
#pragma unroll
        for (int a = 0; a < 2; ++a)
#pragma unroll
            for (int b = 0; b < 2; ++b)
#pragma unroll
                for (int m = 0; m < 4; ++m)
#pragma unroll
                    for (int n = 0; n < 2; ++n) acc[a][b][m][n] = (f32x4){0.f, 0.f, 0.f, 0.f};
        cur = nxt; cA = nA; cB = nB; ++ui;
        if constexpr (ALIGN_EPI) { if (wr == 1) PG8_BAR; }
    }
    PG8_WAIT_V(0);
    if constexpr (!ALIGN_EPI) { if (wr == 0) PG8_BAR; }
    PG8_BAR;
#undef PG8_SA
#undef PG8_SB
#undef PG8_STAGE
#undef PG8_LDA
#undef PG8_LDB
#undef PG8_MMA
#undef PG8_WAIT_V
#undef PG8_WAIT_L
#undef PG8_BAR
#undef PG8_SCHED
#undef PG8_APTR
#undef PG8_BPTR
}
}

struct Params {
    const float* x; const float* meta; const float* norm_w; const float* w_in; const float* sinks; const float* mu; const float* w0; const float* w2;
    const float* a0; const float* a2; const float* k_k; const float* k_a; const float* r_k; const float* ln_w; const float* ln_b;
    const float* w_ba; const float* w_br; const float* w_out; const float* fnw;
    float* out; unsigned char* ws;
};

struct EpiP1 {
    static constexpr bool PERM = true;
    bf16_t *Q, *KV, *RKV, *WA; const float* rope;
    __device__ __forceinline__ void operator()(const f32x4 (&acc)[2][2][4][2], const pg8::Unit& u, int wr, int wc, int fr, int fq) const {
        asm volatile("" : "+v"(fr), "+v"(fq));
        const int pn = u.pn, row0 = u.pm * 256 + wr * 64 + fr, cl = wc * 32 + 8 * fq;
        if (pn <= 4) {
            const float sc = pn < 4 ? QSCALE : 1.f;
#pragma unroll
            for (int ai = 0; ai < 2; ++ai)
#pragma unroll
                for (int m = 0; m < 4; ++m) {
                    const int row = row0 + ai * 128 + m * 16;
                    const int pos = row < MREAL ? (row & (SEQ - 1)) + NMETA : row - MREAL;
                    const float* rp = rope + (size_t)pos * 64;
#pragma unroll
                    for (int bj = 0; bj < 2; ++bj) {
                        const int col = bj * 128 + cl;
                        f32x4 v0 = acc[ai][bj][m][0], v1 = acc[ai][bj][m][1];
                        u32x4 w;
                        if (pn == 4 && bj == 1) {
                            w.x = cvt_pk_bf16(v0[0], v0[1]); w.y = cvt_pk_bf16(v0[2], v0[3]); w.z = cvt_pk_bf16(v1[0], v1[1]); w.w = cvt_pk_bf16(v1[2], v1[3]);
                        } else {
                            const int i0 = (col & 63) >> 1;
                            const f32x4 c = *(const f32x4*)(rp + i0), s = *(const f32x4*)(rp + 32 + i0);
                            w.x = cvt_pk_bf16((v0[0] * c[0] - v0[1] * s[0]) * sc, (v0[1] * c[0] + v0[0] * s[0]) * sc);
                            w.y = cvt_pk_bf16((v0[2] * c[1] - v0[3] * s[1]) * sc, (v0[3] * c[1] + v0[2] * s[1]) * sc);
                            w.z = cvt_pk_bf16((v1[0] * c[2] - v1[1] * s[2]) * sc, (v1[1] * c[2] + v1[0] * s[2]) * sc);
                            w.w = cvt_pk_bf16((v1[2] * c[3] - v1[3] * s[3]) * sc, (v1[3] * c[3] + v1[2] * s[3]) * sc);
                        }
                        bf16_t* dst = pn < 4 ? Q + (size_t)row * 1024 + pn * 256 + col : KV + (size_t)row * 256 + col;
                        *(u32x4*)dst = w;
                    }
                }
        } else {
#pragma unroll
            for (int ai = 0; ai < 2; ++ai)
#pragma unroll
                for (int m = 0; m < 4; ++m) {
                    const int row = row0 + ai * 128 + m * 16;
#pragma unroll
                    for (int bj = 0; bj < 2; ++bj) {
                        const int col = bj * 128 + cl;
                        const f32x4 v0 = acc[ai][bj][m][0], v1 = acc[ai][bj][m][1];
                        u32x4 w; w.x = cvt_pk_bf16(v0[0], v0[1]); w.y = cvt_pk_bf16(v0[2], v0[3]); w.z = cvt_pk_bf16(v1[0], v1[1]); w.w = cvt_pk_bf16(v1[2], v1[3]);
                        if (pn < 17) *(u32x4*)(RKV + (size_t)row * 3072 + (pn - 5) * 256 + col) = w;
                        else if (bj == 0) *(u32x4*)(WA + (size_t)row * 128 + col) = w;
                    }
                }
        }
    }
};
struct EpiGate {
    static constexpr bool PERM = true;
    bf16_t *Q, *RW, *SG;
    __device__ __forceinline__ void operator()(const f32x4 (&acc)[2][2][4][2], const pg8::Unit& u, int wr, int wc, int fr, int fq) const {
        asm volatile("" : "+v"(fr), "+v"(fq));
        const int pn = u.pn, row0 = u.pm * 256 + wr * 64 + fr, cl = wc * 32 + 8 * fq;
#pragma unroll
        for (int ai = 0; ai < 2; ++ai)
#pragma unroll
            for (int m = 0; m < 4; ++m) {
                const int row = row0 + ai * 128 + m * 16;
#pragma unroll
                for (int bj = 0; bj < 2; ++bj) {
                    const int col = bj * 128 + cl;
                    const f32x4 v0 = acc[ai][bj][m][0], v1 = acc[ai][bj][m][1];
                    u32x4 w;
                    if (pn < 8) {
                        bf16_t* p = (pn < 4 ? Q + (size_t)row * 1024 + pn * 256 : RW + (size_t)row * 1024 + (pn - 4) * 256) + col;
                        const u32x4 a = *(const u32x4*)p;
                        w.x = cvt_pk_bf16(bflo(a.x) * siluf_(v0[0]), bfhi(a.x) * siluf_(v0[1]));
                        w.y = cvt_pk_bf16(bflo(a.y) * siluf_(v0[2]), bfhi(a.y) * siluf_(v0[3]));
                        w.z = cvt_pk_bf16(bflo(a.z) * siluf_(v1[0]), bfhi(a.z) * siluf_(v1[1]));
                        w.w = cvt_pk_bf16(bflo(a.w) * siluf_(v1[2]), bfhi(a.w) * siluf_(v1[3]));
                        *(u32x4*)p = w;
                    } else {
                        w.x = cvt_pk_bf16(sigmoidf_(v0[0]), sigmoidf_(v0[1])); w.y = cvt_pk_bf16(sigmoidf_(v0[2]), sigmoidf_(v0[3]));
                        w.z = cvt_pk_bf16(sigmoidf_(v1[0]), sigmoidf_(v1[1])); w.w = cvt_pk_bf16(sigmoidf_(v1[2]), sigmoidf_(v1[3]));
                        *(u32x4*)(SG + (size_t)row * 2048 + (pn - 8) * 256 + col) = w;
                    }
                }
                asm volatile("" ::: "memory");
            }
    }
};
struct EpiBranch {
    static constexpr bool PERM = true;
    bf16_t* MG; const bf16_t* SG;
    __device__ __forceinline__ void operator()(const f32x4 (&acc)[2][2][4][2], const pg8::Unit& u, int wr, int wc, int fr, int fq) const {
        asm volatile("" : "+v"(fr), "+v"(fq));
        const int pn = u.pn, pc = pn & 3, row0 = u.pm * 256 + wr * 64 + fr, cl = wc * 32 + 8 * fq;
#pragma unroll
        for (int ai = 0; ai < 2; ++ai)
#pragma unroll
            for (int m = 0; m < 4; ++m) {
                const int row = row0 + ai * 128 + m * 16;
#pragma unroll
                for (int bj = 0; bj < 2; ++bj) {
                    const int col = pc * 256 + bj * 128 + cl;
                    const f32x4 v0 = acc[ai][bj][m][0], v1 = acc[ai][bj][m][1];
                    const u32x4 s = *(const u32x4*)(SG + (size_t)row * 2048 + (pn >= 4 ? 1024 : 0) + col);
                    bf16_t* p = MG + (size_t)row * 1024 + col;
                    float o0 = bflo(s.x) * v0[0], o1 = bfhi(s.x) * v0[1], o2 = bflo(s.y) * v0[2], o3 = bfhi(s.y) * v0[3];
                    float o4 = bflo(s.z) * v1[0], o5 = bfhi(s.z) * v1[1], o6 = bflo(s.w) * v1[2], o7 = bfhi(s.w) * v1[3];
                    if (pn >= 4) { const u32x4 a = *(const u32x4*)p;
                        o0 += bflo(a.x); o1 += bfhi(a.x); o2 += bflo(a.y); o3 += bfhi(a.y); o4 += bflo(a.z); o5 += bfhi(a.z); o6 += bflo(a.w); o7 += bfhi(a.w); }
                    u32x4 w; w.x = cvt_pk_bf16(o0, o1); w.y = cvt_pk_bf16(o2, o3); w.z = cvt_pk_bf16(o4, o5); w.w = cvt_pk_bf16(o6, o7);
                    *(u32x4*)p = w;
                }
                asm volatile("" ::: "memory");
            }
    }
};
struct EpiOut {
    static constexpr bool PERM = false;
    const float* x; float* out; LAS float* rowss;
    __device__ __forceinline__ void operator()(const f32x4 (&acc)[2][2][4][2], const pg8::Unit& u, int wr, int wc, int fr, int fq) const {
        asm volatile("" : "+v"(fr), "+v"(fq));
        const int row0 = u.pm * 256 + wr * 64 + fr, col0 = u.pn * 256 + wc * 32 + 4 * fq;
#pragma unroll
        for (int ai = 0; ai < 2; ++ai)
#pragma unroll
            for (int m = 0; m < 4; ++m) {
                const size_t off = (size_t)(row0 + ai * 128 + m * 16) * 1024 + col0;
                float ss = 0.f;
#pragma unroll
                for (int bj = 0; bj < 2; ++bj)
#pragma unroll
                    for (int n = 0; n < 2; ++n) {
                        const f32x4 h = *(const f32x4*)(x + off + bj * 128 + n * 16) + acc[ai][bj][m][n];
                        ss += (h[0] * h[0] + h[1] * h[1]) + (h[2] * h[2] + h[3] * h[3]);
                        *(f32x4*)(out + off + bj * 128 + n * 16) = h;
                    }
                ss += __shfl_xor(ss, 16); ss += __shfl_xor(ss, 32);
                if (fq == 0) __hip_atomic_fetch_add(rowss + ai * 128 + wr * 64 + m * 16 + fr, ss, __ATOMIC_RELAXED, __HIP_MEMORY_SCOPE_WORKGROUP);
                asm volatile("" ::: "memory");
            }
    }
};

__device__ __forceinline__ int win_dest(int n) {
    if (n < 1152) { const int hh = n >> 6, d = n & 63; return (hh << 6) + 2 * (d & 31) + (d >> 5); }
    if (n < 1280) return n;
    if (n < 2304) return 4608 + (n - 1280);
    if (n < 5504) return 1280 + (n - 2304);
    if (n < 6528) return 5632 + (n - 5504);
    return 6656 + (n - 6528);
}
template <bool MAPPED>
__device__ __forceinline__ void p0_transpose_item(const float* W, int N, bf16_t* WT, LAS float* scr, int item, int lane) {
    const int nblk = N / 32, kb = item / nblk, nb = item % nblk, k0 = 64 * kb, n0 = 32 * nb;
#pragma unroll 8
    for (int i = 0; i < 32; ++i) { const int kk = 2 * i + (lane >> 5); scr[kk * 33 + (lane & 31)] = W[(size_t)(k0 + kk) * N + n0 + (lane & 31)]; }
    asm volatile("s_waitcnt lgkmcnt(0)" ::: "memory");
    const int c = lane & 7;
#pragma unroll
    for (int j = 0; j < 4; ++j) { const int n = (lane >> 3) + 8 * j; const LAS float* s = scr + (8 * c) * 33 + n;
        u32x4 o; o.x = cvt_pk_bf16(s[0 * 33], s[1 * 33]); o.y = cvt_pk_bf16(s[2 * 33], s[3 * 33]); o.z = cvt_pk_bf16(s[4 * 33], s[5 * 33]); o.w = cvt_pk_bf16(s[6 * 33], s[7 * 33]);
        const int dr = MAPPED ? win_dest(n0 + n) : n0 + n;
        *(u32x4*)(WT + (size_t)dr * 1024 + k0 + 8 * c) = o; }
    asm volatile("s_waitcnt lgkmcnt(0)" ::: "memory");
}
__device__ __forceinline__ void rms_row_to_bf16(const float* xrow, const float* nw, bf16_t* orow, int lane) {
    const f32x4* xr = (const f32x4*)xrow + lane; const f32x4* wr4 = (const f32x4*)nw + lane;
    f32x4 v[4]; float s = 0.f;
#pragma unroll
    for (int j = 0; j < 4; ++j) { v[j] = xr[64 * j]; s += (v[j][0] * v[j][0] + v[j][1] * v[j][1]) + (v[j][2] * v[j][2] + v[j][3] * v[j][3]); }
    const float rstd = 1.f / sqrtf(wave_sum(s) * (1.f / DM) + RMS_EPS);
    u32x2* o8 = (u32x2*)orow + lane;
#pragma unroll
    for (int j = 0; j < 4; ++j) { const f32x4 w = wr4[64 * j]; u32x2 o; o.x = cvt_pk_bf16(v[j][0] * rstd * w[0], v[j][1] * rstd * w[1]); o.y = cvt_pk_bf16(v[j][2] * rstd * w[2], v[j][3] * rstd * w[3]); o8[64 * j] = o; }
}
__device__ __forceinline__ void p0_prologue(const Params& P, LAS unsigned char* lds, int G) {
    const int tid = threadIdx.x, lane = tid & 63, wave = tid >> 6;
    LAS float* scr = (LAS float*)(lds + wave * 16384);
    const int gw = blockIdx.x * 8 + wave, NGW = G * 8;
    bf16_t* WinT = (bf16_t*)(P.ws + WS_WIN); bf16_t* WbT = (bf16_t*)(P.ws + WS_WB); bf16_t* WoT = (bf16_t*)(P.ws + WS_WOUT);
    constexpr int I_IN = 16 * (NIN_SRC / 32), I_SQ = 16 * 32;
    for (int it = gw; it < I_IN + 3 * I_SQ; it += NGW) {
        int r = it;
        if (r < I_IN) { p0_transpose_item<true>(P.w_in, NIN_SRC, WinT, scr, r, lane); continue; } r -= I_IN;
        if (r < I_SQ) { p0_transpose_item<false>(P.w_ba, 1024, WbT, scr, r, lane); continue; } r -= I_SQ;
        if (r < I_SQ) { p0_transpose_item<false>(P.w_br, 1024, WbT + (size_t)1024 * 1024, scr, r, lane); continue; } r -= I_SQ;
        p0_transpose_item<false>(P.w_out, 1024, WoT, scr, r, lane);
    }
    for (int i = blockIdx.x * 512 + tid; i < 16384; i += G * 512) *((u32x4*)(WinT + (size_t)4480 * 1024) + i) = (u32x4){0u, 0u, 0u, 0u};
    bf16_t* U = (bf16_t*)(P.ws + WS_U);
    for (int m = gw; m < MREAL + NMETA; m += NGW) {
        const float* src = m < MREAL ? P.x + (size_t)m * DM : P.meta + (size_t)(m - MREAL) * DM;
        rms_row_to_bf16(src, P.norm_w, U + (size_t)m * DM, lane);
    }
    float* rope = (float*)(P.ws + WS_ROPE);
    for (int i = blockIdx.x * 512 + tid; i < TT * 32; i += G * 512) {
        const int pos = i >> 5, k = i & 31;
        const double inv = exp(-9.210340371976184 * (double)k / 32.0);
        const double ang = (double)pos * inv;
        rope[pos * 64 + k] = (float)cos(ang); rope[pos * 64 + 32 + k] = (float)sin(ang);
    }
}

constexpr int KS_STRIDE = 144;
constexpr int VT_STRIDE = 520;
constexpr int ATT_KS = 0, ATT_VT = 256 * KS_STRIDE;
__device__ __forceinline__ int crow(int r, int hi) { return (r & 3) + 8 * (r >> 2) + 4 * hi; }
__device__ __forceinline__ void attn_unit(const Params& P, LAS unsigned char* lds, int unit) {
    const int tid = threadIdx.x, lane = tid & 63, wid = tid >> 6, qc = lane & 31, hi = lane >> 5;
    const int g = unit & 1, qb = (unit >> 1) & 63, b = unit >> 7;
    bf16_t* Q = (bf16_t*)(P.ws + WS_Q); const bf16_t* KV = (const bf16_t*)(P.ws + WS_KV);
    const int rb = b * SEQ + qb * 128;
    __syncthreads();
#pragma unroll
    for (int i = 0; i < 4; ++i) {
        const int id = tid + 512 * i, c = id >> 3, ch = id & 7;
        int row; bool ok = true;
        if (c >= 128) row = rb + c - 128; else if (qb > 0) row = rb - 128 + c; else { ok = c >= 112; row = MREAL + c - 112; }
        u32x4 kq = (u32x4){0u, 0u, 0u, 0u}, vq = kq;
        if (ok) { kq = *(const u32x4*)(KV + (size_t)row * 256 + g * 64 + ch * 8); vq = *(const u32x4*)(KV + (size_t)row * 256 + 128 + g * 64 + ch * 8); }
        *(LAS u32x4*)(lds + ATT_KS + c * KS_STRIDE + ch * 16) = kq;
        LAS unsigned short* vt = (LAS unsigned short*)(lds + ATT_VT) + (ch * 8) * (VT_STRIDE / 2) + c;
        vt[0 * (VT_STRIDE / 2)] = (unsigned short)(vq.x & 0xffff); vt[1 * (VT_STRIDE / 2)] = (unsigned short)(vq.x >> 16);
        vt[2 * (VT_STRIDE / 2)] = (unsigned short)(vq.y & 0xffff); vt[3 * (VT_STRIDE / 2)] = (unsigned short)(vq.y >> 16);
        vt[4 * (VT_STRIDE / 2)] = (unsigned short)(vq.z & 0xffff); vt[5 * (VT_STRIDE / 2)] = (unsigned short)(vq.z >> 16);
        vt[6 * (VT_STRIDE / 2)] = (unsigned short)(vq.w & 0xffff); vt[7 * (VT_STRIDE / 2)] = (unsigned short)(vq.w >> 16);
    }
    __syncthreads();
    const int h = g * 8 + wid;
    const float sink2 = P.sinks[h] * LOG2E;
    for (int qt = 0; qt < 4; ++qt) {
        bf16_t* qrow = Q + (size_t)(rb + qt * 32 + qc) * 1024 + h * 64;
        bf16x8 qf[4];
#pragma unroll
        for (int s = 0; s < 4; ++s) qf[s] = *(const bf16x8*)(qrow + s * 16 + hi * 8);
        f32x16 sc[5];
#pragma unroll
        for (int jj = 0; jj < 5; ++jj) {
            sc[jj] = (f32x16){0.f};
            const LAS unsigned char* kp = lds + ATT_KS + (32 * (qt + jj) + qc) * KS_STRIDE + hi * 16;
#pragma unroll
            for (int s = 0; s < 4; ++s) { const bf16x8 kf = *(const LAS bf16x8*)(kp + s * 32); sc[jj] = __builtin_amdgcn_mfma_f32_32x32x16_bf16(kf, qf[s], sc[jj], 0, 0, 0); }
        }
        float mx = sink2;
#pragma unroll
        for (int jj = 0; jj < 5; ++jj)
#pragma unroll
            for (int r = 0; r < 16; ++r) {
                const int kr = crow(r, hi);
                bool ok = true;
                if (jj == 0) ok = kr >= qc + 1;
                if (jj == 4) ok = kr <= qc;
                if (qb == 0) ok = ok && (32 * (qt + jj) + kr >= 112);
                const float v = ok ? sc[jj][r] : -1e30f;
                sc[jj][r] = v; mx = fmaxf(mx, v);
            }
        { auto rr = __builtin_amdgcn_permlane32_swap(__float_as_uint(mx), __float_as_uint(mx), false, false); mx = fmaxf(__uint_as_float(rr[0]), __uint_as_float(rr[1])); }
        float l = 0.f;
#pragma unroll
        for (int jj = 0; jj < 5; ++jj)
#pragma unroll
            for (int r = 0; r < 16; ++r) { const float p = __builtin_amdgcn_exp2f(sc[jj][r] - mx); sc[jj][r] = p; l += p; }
        { auto rr = __builtin_amdgcn_permlane32_swap(__float_as_uint(l), __float_as_uint(l), false, false); l = __uint_as_float(rr[0]) + __uint_as_float(rr[1]); }
        l += __builtin_amdgcn_exp2f(sink2 - mx);
        const float rl = 1.f / l;
        f32x16 o[2]; o[0] = (f32x16){0.f}; o[1] = (f32x16){0.f};
#pragma unroll
        for (int jj = 0; jj < 5; ++jj)
#pragma unroll
            for (int t = 0; t < 2; ++t) {
                u32x4 pw; pw.x = cvt_pk_bf16(sc[jj][8 * t + 0], sc[jj][8 * t + 1]); pw.y = cvt_pk_bf16(sc[jj][8 * t + 2], sc[jj][8 * t + 3]);
                pw.z = cvt_pk_bf16(sc[jj][8 * t + 4], sc[jj][8 * t + 5]); pw.w = cvt_pk_bf16(sc[jj][8 * t + 6], sc[jj][8 * t + 7]);
                const bf16x8 pf = __builtin_bit_cast(bf16x8, pw);
#pragma unroll
                for (int dt = 0; dt < 2; ++dt) {
                    const LAS unsigned char* vp = lds + ATT_VT + (32 * dt + qc) * VT_STRIDE + (32 * (qt + jj) + 16 * t + 4 * hi) * 2;
                    const u32x2 lo = *(const LAS u32x2*)vp, hi2 = *(const LAS u32x2*)(vp + 16);
                    const u32x4 vw = (u32x4){lo.x, lo.y, hi2.x, hi2.y};
                    o[dt] = __builtin_amdgcn_mfma_f32_32x32x16_bf16(__builtin_bit_cast(bf16x8, vw), pf, o[dt], 0, 0, 0);
                }
            }
#pragma unroll
        for (int dt = 0; dt < 2; ++dt)
#pragma unroll
            for (int rq = 0; rq < 4; ++rq) {
                u32x2 w; w.x = cvt_pk_bf16(o[dt][4 * rq + 0] * rl, o[dt][4 * rq + 1] * rl); w.y = cvt_pk_bf16(o[dt][4 * rq + 2] * rl, o[dt][4 * rq + 3] * rl);
                *(u32x2*)(qrow + 32 * dt + 8 * rq + 4 * hi) = w;
            }
    }
}

constexpr int TC = 32;
constexpr int SC_W2 = 0, SC_A2 = 16384, SC_TW = 32768, SC_ZAL = 40960, SC_R = 49152, SC_W = 57344, SC_K = 65536, SC_A = 73728, SC_B = 81920, SC_V = 90112, SC_Y = 98304, SC_BON = 106496;
__device__ __forceinline__ void scan_item(const Params& P, LAS unsigned char* lds, int item) {
    const int tid = threadIdx.x, lane = tid & 63, wid = tid >> 6;
    const int b = item >> 4, h = item & 15, hj = h * 64 + lane;
    const bf16_t* RKV = (const bf16_t*)(P.ws + WS_RKV); const bf16_t* WA = (const bf16_t*)(P.ws + WS_WA); bf16_t* RW = (bf16_t*)(P.ws + WS_RW);
    LAS float* w2s = (LAS float*)(lds + SC_W2); LAS float* a2s = (LAS float*)(lds + SC_A2); LAS float* tw = (LAS float*)(lds + SC_TW); LAS float* zal = (LAS float*)(lds + SC_ZAL);
    LAS float* Rs = (LAS float*)(lds + SC_R); LAS float* Ws = (LAS float*)(lds + SC_W); LAS float* Ks = (LAS float*)(lds + SC_K); LAS float* As = (LAS float*)(lds + SC_A);
    LAS float* Bs = (LAS float*)(lds + SC_B); LAS float* Vs = (LAS float*)(lds + SC_V); LAS float* Ys = (LAS float*)(lds + SC_Y); LAS float* BON = (LAS float*)(lds + SC_BON);
    __syncthreads();
    for (int i = tid; i < 4096; i += 512) { const int r = i >> 6, c = i & 63; w2s[i] = P.w2[(size_t)r * 1024 + h * 64 + c]; a2s[i] = P.a2[(size_t)r * 1024 + h * 64 + c]; }
    const float mu_r = P.mu[hj], mu_k = P.mu[1024 + hj], mu_v = P.mu[2048 + hj], mu_wl = P.mu[3072 + lane], mu_al = P.mu[3136 + lane];
    const float w0v = P.w0[hj], a0v = P.a0[hj], kkv = P.k_k[hj], kav = P.k_a[hj], rkv = P.r_k[hj], lnw = P.ln_w[hj], lnb = P.ln_b[hj];
    float S[8];
#pragma unroll
    for (int c = 0; c < 8; ++c) S[c] = 0.f;
    const int srow = tid >> 3, scg = tid & 7;
    for (int t0 = 0; t0 < TT; t0 += TC) {
        const int nt = (TT - t0) < TC ? (TT - t0) : TC;
        float zr[4], zk[4], zv[4];
        {
            float pr = 0.f, pk = 0.f, pv = 0.f, pwl = 0.f, pal = 0.f;
            const int tp = t0 + 4 * wid - 1;
            if (tp >= 0 && tp < TT) { const size_t row = tp < NMETA ? (size_t)MREAL + tp : (size_t)b * SEQ + tp - NMETA;
                pr = bf2f(RKV[row * 3072 + hj]); pk = bf2f(RKV[row * 3072 + 1024 + hj]); pv = bf2f(RKV[row * 3072 + 2048 + hj]); pwl = bf2f(WA[row * 128 + lane]); pal = bf2f(WA[row * 128 + 64 + lane]); }
#pragma unroll
            for (int q = 0; q < 4; ++q) {
                const int tl = 4 * wid + q, tk = t0 + tl;
                float cr = 0.f, ck = 0.f, cv = 0.f, cwl = 0.f, cal = 0.f;
                if (tk < TT) { const size_t row = tk < NMETA ? (size_t)MREAL + tk : (size_t)b * SEQ + tk - NMETA;
                    cr = bf2f(RKV[row * 3072 + hj]); ck = bf2f(RKV[row * 3072 + 1024 + hj]); cv = bf2f(RKV[row * 3072 + 2048 + hj]); cwl = bf2f(WA[row * 128 + lane]); cal = bf2f(WA[row * 128 + 64 + lane]); }
                zr[q] = cr + (pr - cr) * mu_r; zk[q] = ck + (pk - ck) * mu_k; zv[q] = cv + (pv - cv) * mu_v;
                tw[tl * 64 + lane] = tanhf(cwl + (pwl - cwl) * mu_wl); zal[tl * 64 + lane] = cal + (pal - cal) * mu_al;
                pr = cr; pk = ck; pv = cv; pwl = cwl; pal = cal;
            }
        }
        __syncthreads();
        float aw[4], aa[4];
#pragma unroll
        for (int q = 0; q < 4; ++q) { aw[q] = w0v; aa[q] = a0v; }
        for (int i = 0; i < 64; ++i) {
            const float wv = w2s[i * 64 + lane], av = a2s[i * 64 + lane];
#pragma unroll
            for (int q = 0; q < 4; ++q) { aw[q] += tw[(4 * wid + q) * 64 + i] * wv; aa[q] += zal[(4 * wid + q) * 64 + i] * av; }
        }
#pragma unroll
        for (int q = 0; q < 4; ++q) {
            const int tl = 4 * wid + q;
            const float y = -aw[q];
            const float sp = fmaxf(y, 0.f) + log1pf(expf(-fabsf(y)));
            const float wlog = -sp - 0.5f;
            const float decay = expf(-expf(wlog));
            const float a = 1.f / (1.f + expf(-aa[q]));
            float kk = zk[q] * kkv;
            const float n2 = wave_sum(kk * kk);
            kk = kk / fmaxf(sqrtf(n2), 1e-12f);
            const float kp = zk[q] * (1.f + (a - 1.f) * kav);
            const float bon = wave_sum(zr[q] * kp * rkv);
            Rs[tl * 64 + lane] = zr[q]; Ws[tl * 64 + lane] = decay; Ks[tl * 64 + lane] = kp; As[tl * 64 + lane] = -kk; Bs[tl * 64 + lane] = kk * a; Vs[tl * 64 + lane] = zv[q];
            if (lane == 0) BON[tl] = bon;
        }
        __syncthreads();
        for (int t = 0; t < nt; ++t) {
            const f32x4 w_0 = *(const LAS f32x4*)(Ws + t * 64 + 8 * scg), w_1 = *(const LAS f32x4*)(Ws + t * 64 + 8 * scg + 4);
            const f32x4 a_0 = *(const LAS f32x4*)(As + t * 64 + 8 * scg), a_1 = *(const LAS f32x4*)(As + t * 64 + 8 * scg + 4);
            const f32x4 b_0 = *(const LAS f32x4*)(Bs + t * 64 + 8 * scg), b_1 = *(const LAS f32x4*)(Bs + t * 64 + 8 * scg + 4);
            const f32x4 k_0 = *(const LAS f32x4*)(Ks + t * 64 + 8 * scg), k_1 = *(const LAS f32x4*)(Ks + t * 64 + 8 * scg + 4);
            const f32x4 r_0 = *(const LAS f32x4*)(Rs + t * 64 + 8 * scg), r_1 = *(const LAS f32x4*)(Rs + t * 64 + 8 * scg + 4);
            const float v = Vs[t * 64 + srow];
            float sa = (S[0] * a_0[0] + S[1] * a_0[1]) + (S[2] * a_0[2] + S[3] * a_0[3]) + (S[4] * a_1[0] + S[5] * a_1[1]) + (S[6] * a_1[2] + S[7] * a_1[3]);
            sa = red8(sa);
#pragma unroll
            for (int c = 0; c < 4; ++c) { S[c] = S[c] * w_0[c] + sa * b_0[c] + v * k_0[c]; S[4 + c] = S[4 + c] * w_1[c] + sa * b_1[c] + v * k_1[c]; }
            float y = (S[0] * r_0[0] + S[1] * r_0[1]) + (S[2] * r_0[2] + S[3] * r_0[3]) + (S[4] * r_1[0] + S[5] * r_1[1]) + (S[6] * r_1[2] + S[7] * r_1[3]);
            y = red8(y);
            if (scg == 0) Ys[t * 64 + srow] = y;
        }
        __syncthreads();
#pragma unroll
        for (int q = 0; q < 4; ++q) {
            const int tl = 4 * wid + q, tk = t0 + tl;
            const float y = Ys[tl * 64 + lane];
            const float mean = wave_sum(y) * (1.f / 64.f);
            const float d = y - mean;
            const float var = wave_sum(d * d) * (1.f / 64.f);
            const float o = d * (1.f / sqrtf(var + GN_EPS)) * lnw + lnb + BON[tl] * Vs[tl * 64 + lane];
            if (tl < nt && tk >= NMETA) RW[((size_t)b * SEQ + tk - NMETA) * 1024 + hj] = f2bf(o);
        }
        __syncthreads();
    }
}

__device__ __forceinline__ void chain_fence() {
    asm volatile("s_waitcnt vmcnt(0) lgkmcnt(0)" ::: "memory");
    __builtin_amdgcn_fence(__ATOMIC_SEQ_CST, "agent");
    asm volatile("s_waitcnt vmcnt(0)" ::: "memory");
    __syncthreads();
}
__device__ __forceinline__ void tail_tile(const Params& P, LAS unsigned char* lds, int pm) {
    const int tid = threadIdx.x, lane = tid & 63, wid = tid >> 6;
    bf16_t* U = (bf16_t*)(P.ws + WS_U); bf16_t* Q = (bf16_t*)(P.ws + WS_Q); bf16_t* RW = (bf16_t*)(P.ws + WS_RW);
    const bf16_t* WinT = (const bf16_t*)(P.ws + WS_WIN); const bf16_t* WbT = (const bf16_t*)(P.ws + WS_WB); const bf16_t* WoT = (const bf16_t*)(P.ws + WS_WOUT);
    bf16_t* SG = (bf16_t*)P.out;
    LAS float* rowss = (LAS float*)(lds + LDS_ROWSS);
    if (tid < 256) rowss[tid] = 0.f;
    if (PHASE_MASK & 0x10) {
        pg8::Gemm g{U, U, WinT + (size_t)NP1 * 1024, 1024, 1 << 30}; pg8::LocalOrder S{pm, 16}; EpiGate E{Q, RW, SG};
        pg8::gemm_phase<EpiGate, pg8::LocalOrder, true>(lds, g, S, E);
    }
    chain_fence();
    if (PHASE_MASK & 0x20) {
        pg8::Gemm g{Q, RW, WbT, 1024, 4}; pg8::LocalOrder S{pm, 8}; EpiBranch E{U, SG};
        pg8::gemm_phase<EpiBranch, pg8::LocalOrder, true>(lds, g, S, E);
    }
    chain_fence();
    if (PHASE_MASK & 0x40) {
        pg8::Gemm g{U, U, WoT, 1024, 1 << 30}; pg8::LocalOrder S{pm, 4}; EpiOut E{P.x, P.out, rowss};
        pg8::gemm_phase<EpiOut, pg8::LocalOrder, true>(lds, g, S, E);
    }
    chain_fence();
    for (int r = wid * 32; r < wid * 32 + 32; ++r) {
        const float rstd = 1.f / sqrtf(rowss[r] * (1.f / DM) + RMS_EPS);
        f32x4* o = (f32x4*)(P.out + (size_t)(pm * 256 + r) * 1024) + lane; const f32x4* fw = (const f32x4*)P.fnw + lane;
#pragma unroll
        for (int j = 0; j < 4; ++j) { const f32x4 v = o[64 * j], w = fw[64 * j]; o[64 * j] = (f32x4){v[0] * rstd * w[0], v[1] * rstd * w[1], v[2] * rstd * w[2], v[3] * rstd * w[3]}; }
    }
    __syncthreads();
}

__global__ void __launch_bounds__(512, 2) fwd_megakernel(Params P) {
    extern __shared__ __attribute__((aligned(16))) unsigned char lds_raw[];
    LAS unsigned char* lds = (LAS unsigned char*)lds_raw;
    cg::grid_group grid = cg::this_grid();
    const int G = gridDim.x;
    if (PHASE_MASK & 1) p0_prologue(P, lds, G);
    __builtin_amdgcn_fence(__ATOMIC_SEQ_CST, "agent"); grid.sync(); __builtin_amdgcn_fence(__ATOMIC_SEQ_CST, "agent");
    if (PHASE_MASK & 2) {
        pg8::Gemm g{(const bf16_t*)(P.ws + WS_U), (const bf16_t*)(P.ws + WS_U), (const bf16_t*)(P.ws + WS_WIN), 1024, 1 << 30};
        pg8::StaticOrder S; S.init(MPAD, NP1, G, (int)blockIdx.x);
        EpiP1 E{(bf16_t*)(P.ws + WS_Q), (bf16_t*)(P.ws + WS_KV), (bf16_t*)(P.ws + WS_RKV), (bf16_t*)(P.ws + WS_WA), (const float*)(P.ws + WS_ROPE)};
        pg8::gemm_phase<EpiP1, pg8::StaticOrder, true>(lds, g, S, E);
    }
    __builtin_amdgcn_fence(__ATOMIC_SEQ_CST, "agent"); grid.sync(); __builtin_amdgcn_fence(__ATOMIC_SEQ_CST, "agent");
    if (G == 256) {
        if (blockIdx.x < 128) { if (PHASE_MASK & 4) scan_item(P, lds, blockIdx.x); }
        else { if (PHASE_MASK & 8) for (int u = blockIdx.x - 128; u < 1024; u += 128) attn_unit(P, lds, u); }
    } else {
        for (int it = blockIdx.x; it < 128 + 1024; it += G) { if (it < 128) { if (PHASE_MASK & 4) scan_item(P, lds, it); } else { if (PHASE_MASK & 8) attn_unit(P, lds, it - 128); } }
    }
    __builtin_amdgcn_fence(__ATOMIC_SEQ_CST, "agent"); grid.sync(); __builtin_amdgcn_fence(__ATOMIC_SEQ_CST, "agent");
    if (PHASE_MASK & 0xF0) for (int pm = blockIdx.x; pm < MREAL / 256; pm += G) tail_tile(P, lds, pm);
}

extern "C" void kernel_launch(void* const* d_in, const int* in_sizes, int n_in, void* d_out, int out_size, void* d_ws, size_t ws_size, hipStream_t stream) {
    static int grid = 0;
    if (grid == 0) {
        if (n_in != 19 || in_sizes[0] != MREAL * DM || out_size != MREAL * DM || ws_size < WS_END) {
            fprintf(stderr, "kernel_launch: unexpected shapes (n_in %d, in0 %d, out %d, ws %zu); nothing launched\n", n_in, n_in > 0 ? in_sizes[0] : -1, out_size, ws_size); grid = -1; return; }
        int dev = 0, cus = 0, per_cu = 0;
        hipGetDevice(&dev);
        hipDeviceGetAttribute(&cus, hipDeviceAttributeMultiprocessorCount, dev);
        hipFuncSetAttribute((const void*)fwd_megakernel, hipFuncAttributeMaxDynamicSharedMemorySize, LDS_BYTES);
        hipOccupancyMaxActiveBlocksPerMultiprocessor(&per_cu, (const void*)fwd_megakernel, 512, LDS_BYTES);
        if (per_cu < 1) { fprintf(stderr, "kernel_launch: occupancy query says %d blocks per CU\n", per_cu); per_cu = 1; }
        grid = cus * 1;
        if (grid > 256) grid = 256;
        (void)hipGetLastError();
    }
    if (grid < 0) return;
    Params p{};
    p.x = (const float*)d_in[0]; p.meta = (const float*)d_in[1]; p.norm_w = (const float*)d_in[2]; p.w_in = (const float*)d_in[3]; p.sinks = (const float*)d_in[4];
    p.mu = (const float*)d_in[5]; p.w0 = (const float*)d_in[6]; p.w2 = (const float*)d_in[7]; p.a0 = (const float*)d_in[8]; p.a2 = (const float*)d_in[9];
    p.k_k = (const float*)d_in[10]; p.k_a = (const float*)d_in[11]; p.r_k = (const float*)d_in[12]; p.ln_w = (const float*)d_in[13]; p.ln_b = (const float*)d_in[14];
    p.w_ba = (const float*)d_in[15]; p.w_br = (const float*)d_in[16]; p.w_out = (const float*)d_in[17]; p.fnw = (const float*)d_in[18];
    p.out = (float*)d_out; p.ws = (unsigned char*)d_ws;
    void* args[] = {&p};
    hipError_t e = hipLaunchCooperativeKernel((const void*)fwd_megakernel, dim3(grid), dim3(512), args, LDS_BYTES, stream);
    if (e != hipSuccess) fprintf(stderr, "cooperative launch failed: %s (grid %d)\n", hipGetErrorString(e), grid);
}
```

```cpp
#include <hip/hip_runtime.h>
#include <hip/hip_cooperative_groups.h>
#include <cstdio>
#include <cstdint>
namespace cg = cooperative_groups;
#ifndef PROBE_PHASE
#define PROBE_PHASE -1
#endif
#ifndef PROBE_BLOCK
#define PROBE_BLOCK 0
#endif
#ifndef PHASE_MASK
#define PHASE_MASK 0xFF
#endif

#define LAS __attribute__((address_space(3)))
typedef unsigned short bf16_t;
typedef short bf16x8 __attribute__((ext_vector_type(8)));
typedef short s16x4 __attribute__((ext_vector_type(4)));
typedef float f32x4 __attribute__((ext_vector_type(4)));
typedef float f32x16 __attribute__((ext_vector_type(16)));
typedef unsigned u32x4 __attribute__((ext_vector_type(4)));
typedef unsigned u32x2 __attribute__((ext_vector_type(2)));

constexpr int DM = 1024, NB = 8, SEQ = 8192, NMETA = 16, TT = SEQ + NMETA;
constexpr int MREAL = NB * SEQ;
constexpr int MPAD = MREAL + 256;
constexpr int NIN_SRC = 8576, NIN = 8704;
constexpr int NP1 = 4608;
constexpr float RMS_EPS = 1e-6f, GN_EPS = 64e-5f;
constexpr float LOG2E = 1.4426950408889634f;
constexpr float QSCALE = 0.125f * LOG2E;

constexpr size_t MiB = 1u << 20;
constexpr size_t WS_WIN = 1 * MiB;
constexpr size_t WS_WB = 18 * MiB;
constexpr size_t WS_WOUT = 22 * MiB;
constexpr size_t WS_ROPE = 24 * MiB;
constexpr size_t WS_U = 27 * MiB;
constexpr size_t WS_Q = 156 * MiB;
constexpr size_t WS_KV = 285 * MiB;
constexpr size_t WS_RKV = 318 * MiB;
constexpr size_t WS_WA = 704 * MiB;
constexpr size_t WS_RW = 721 * MiB;
constexpr size_t WS_END = 849 * MiB;

constexpr int LDS_STAGE = 131072;
constexpr int LDS_ROWSS = 131072;
constexpr int LDS_BYTES = 147456;

typedef float f32x2_t __attribute__((ext_vector_type(2))); typedef __bf16 bf16x2_t __attribute__((ext_vector_type(2)));
__device__ __forceinline__ unsigned cvt_pk_bf16(float lo, float hi) { const f32x2_t v = {lo, hi}; const bf16x2_t b = __builtin_convertvector(v, bf16x2_t); return __builtin_bit_cast(unsigned, b); }
__device__ __forceinline__ float bf2f(unsigned short b) { return __uint_as_float((unsigned)b << 16); }
__device__ __forceinline__ float bflo(unsigned w) { return __uint_as_float(w << 16); }
__device__ __forceinline__ float bfhi(unsigned w) { return __uint_as_float(w & 0xffff0000u); }
__device__ __forceinline__ unsigned short f2bf(float f) { return (unsigned short)(cvt_pk_bf16(f, 0.f) & 0xffffu); }
__device__ __forceinline__ float wave_sum(float v) {
#pragma unroll
    for (int o = 1; o < 64; o <<= 1) v += __shfl_xor(v, o);
    return v;
}
template <int CTRL> __device__ __forceinline__ float dppf(float v) {
    return __builtin_bit_cast(float, __builtin_amdgcn_update_dpp(0, __builtin_bit_cast(int, v), CTRL, 0xF, 0xF, true));
}
__device__ __forceinline__ float red8(float v) {
    v += dppf<0xB1>(v);
    v += dppf<0x4E>(v);
    v += dppf<0x141>(v);
    return v;
}
__device__ __forceinline__ float sigmoidf_(float x) { return __builtin_amdgcn_rcpf(1.f + __builtin_amdgcn_exp2f(-x * LOG2E)); }
__device__ __forceinline__ float siluf_(float x) { return x * sigmoidf_(x); }

namespace pg8 {
constexpr int BM = 256, BK = 64, HALF = 128, HTB = HALF * BK * 2, STAGE_BYTES = 8 * HTB, NXCD = 8, WGM = 8;
__host__ __device__ __forceinline__ int lds_byte(int r, int c) { const int st = (r >> 4) * 2 + (c >> 5), rr = r & 15, cc = c & 31, ob = rr * 64 + cc * 2; return st * 1024 + (ob ^ (((ob >> 9) & 1) << 5)); }
__host__ __device__ __forceinline__ void stage_rc(int b, int& R, int& C) { const int st = b / 1024, sb = b % 1024, swz = sb ^ (((sb >> 9) & 1) << 5); R = (st >> 1) * 16 + swz / 64; C = (st & 1) * 32 + (swz % 64) / 2; }
__host__ __device__ __forceinline__ int perm32(int rho) { const int n = rho >> 4, i = rho & 15; return 8 * (i >> 2) + 4 * n + (i & 3); }

struct Unit { int pm, pn; };
struct Gemm { const bf16_t* A; const bf16_t* A2; const bf16_t* Bt; int K; int asplit; };

struct StaticOrder {
    int nM, nN, nwg, G, c;
    __device__ void init(int M, int N, int G_, int c_) { nM = M / BM; nN = N / BM; nwg = nM * nN; G = G_; c = c_; }
    __device__ bool next(int i, Unit& u) const {
        const long L = (long)i * G + c; if (L >= nwg) return false;
        int wgid = (int)L; { const int q = nwg / NXCD, r = nwg % NXCD, xcd = wgid % NXCD, off = wgid / NXCD; wgid = (xcd < r ? xcd * (q + 1) : r * (q + 1) + (xcd - r) * q) + off; }
        const int nig = WGM * nN, gid = wgid / nig, fm = gid * WGM, gsz = (nM - fm) < WGM ? (nM - fm) : WGM;
        u.pm = fm + ((wgid % nig) % gsz); u.pn = (wgid % nig) / gsz; return true;
    }
};
struct LocalOrder {
    int pm, n;
    __device__ LocalOrder(int pm_, int n_) : pm(pm_), n(n_) { asm volatile("" : "+s"(n)); }
    __device__ bool next(int i, Unit& u) const { if (i >= n) return false; u.pm = pm; u.pn = i; return true; }
};

template <class Epi, class Sched, bool ALIGN_EPI>
__device__ __forceinline__ void gemm_phase(LAS unsigned char* lds, const Gemm g, const Sched& S, const Epi& E) {
    int tid_ = threadIdx.x; asm volatile("" : "+v"(tid_));
    const int tid = tid_, wid = __builtin_amdgcn_readfirstlane(tid >> 6), lane = tid & 63, wr = wid >> 2, wc = wid & 3, fr = lane & 15, fq = lane >> 4;
    const int K = g.K, nt = K / BK;
    unsigned voffA[2], voffB[2];
#pragma unroll
    for (int i = 0; i < 2; ++i) { int R, C; stage_rc(tid * 16 + i * 8192, R, C); const int Rb = Epi::PERM ? ((R & ~31) + perm32(R & 31)) : R;
        voffA[i] = (unsigned)(R * K + C) * 2u; voffB[i] = (unsigned)(Rb * K + C) * 2u; }
    const size_t kstep = (size_t)(BK * 2);
    const size_t hstep = (size_t)HALF * K * 2;
    const size_t tstep = 2 * hstep;
    const unsigned ldsw = (unsigned)wid * 1024u;
    const int aoff = lds_byte(wr * 64 + fr, fq * 8), boff = lds_byte(wc * 32 + fr, fq * 8);
#define PG8_SA(b, h) (((b) * 2 + (h)) * HTB)
#define PG8_SB(b, h) ((4 + (b) * 2 + (h)) * HTB)
#define PG8_STAGE(bufoff, gbase, voff) do { _Pragma("unroll") for (int _i = 0; _i < 2; ++_i) \
        __builtin_amdgcn_global_load_lds((const unsigned*)((const char*)(gbase) + (voff)[_i]), (LAS unsigned*)(lds + (bufoff) + ldsw + _i * 8192), 16, 0, 0); } while (0)
#define PG8_LDA(dst, b, h) do { _Pragma("unroll") for (int m = 0; m < 4; ++m) _Pragma("unroll") for (int k = 0; k < 2; ++k) dst[m][k] = *(const LAS bf16x8*)(lds + PG8_SA(b, h) + aoff + m * 2048 + k * 1024); } while (0)
#define PG8_LDB(dst, b, h) do { _Pragma("unroll") for (int n = 0; n < 2; ++n) _Pragma("unroll") for (int k = 0; k < 2; ++k) dst[n][k] = *(const LAS bf16x8*)(lds + PG8_SB(b, h) + boff + n * 2048 + k * 1024); } while (0)
#define PG8_MMA(ai, bj, At, Bt) do { __builtin_amdgcn_s_setprio(1); _Pragma("unroll") for (int m = 0; m < 4; ++m) _Pragma("unroll") for (int n = 0; n < 2; ++n) _Pragma("unroll") for (int k = 0; k < 2; ++k) \
        acc[ai][bj][m][n] = __builtin_amdgcn_mfma_f32_16x16x32_bf16(Bt[n][k], At[m][k], acc[ai][bj][m][n], 0, 0, 0); __builtin_amdgcn_s_setprio(0); } while (0)
#define PG8_WAIT_V(n) asm volatile("s_waitcnt vmcnt(" #n ")" ::: "memory")
#define PG8_WAIT_L(n) asm volatile("s_waitcnt lgkmcnt(" #n ")" ::: "memory")
#define PG8_BAR __builtin_amdgcn_s_barrier()
#define PG8_SCHED __builtin_amdgcn_sched_barrier(0)
#define PG8_APTR(u) ((const char*)((u).pn >= g.asplit ? g.A2 : g.A) + (size_t)(u).pm * tstep)
#define PG8_BPTR(u) ((const char*)g.Bt + (size_t)(u).pn * tstep)
    Unit cur, nxt; int ui = 0;
    if (!S.next(0, cur)) return;
    f32x4 acc[2][2][4][2];
#pragma unroll
    for (int a = 0; a < 2; ++a)
#pragma unroll
        for (int b = 0; b < 2; ++b)
#pragma unroll
            for (int m = 0; m < 4; ++m)
#pragma unroll
                for (int n = 0; n < 2; ++n) acc[a][b][m][n] = (f32x4){0.f, 0.f, 0.f, 0.f};
    bf16x8 At[4][2], B0[2][2], B1[2][2];
    const char* cA = PG8_APTR(cur); const char* cB = PG8_BPTR(cur);
    PG8_STAGE(PG8_SB(0, 0), cB, voffB); PG8_STAGE(PG8_SB(0, 1), cB + hstep, voffB); PG8_STAGE(PG8_SA(0, 0), cA, voffA); PG8_STAGE(PG8_SA(0, 1), cA + hstep, voffA);
    if (wr == 1) PG8_BAR;
    PG8_WAIT_V(2); PG8_BAR;
    PG8_STAGE(PG8_SB(1, 0), cB + kstep, voffB); PG8_STAGE(PG8_SA(1, 0), cA + kstep, voffA); PG8_STAGE(PG8_SB(1, 1), cB + hstep + kstep, voffB);
    PG8_WAIT_V(6); PG8_BAR;
    for (;;) {
        const bool has_next = S.next(ui + 1, nxt);
        const char* nA = has_next ? PG8_APTR(nxt) : cA; const char* nB = has_next ? PG8_BPTR(nxt) : cB;
        for (int t = 0; t < nt; t += 2) {
            const bool last = (t == nt - 2);
            const char* a1 = cA + (size_t)(t + 1) * kstep;
            const char* a2 = last ? nA : cA + (size_t)(t + 2) * kstep; const char* b2 = last ? nB : cB + (size_t)(t + 2) * kstep;
            const char* a3 = a2 + kstep; const char* b3 = b2 + kstep;
            PG8_LDB(B0, 0, 0); PG8_LDB(B1, 0, 1); PG8_SCHED; PG8_LDA(At, 0, 0); PG8_STAGE(PG8_SA(1, 1), a1 + hstep, voffA);
            PG8_WAIT_V(8); PG8_WAIT_L(0); PG8_BAR; PG8_MMA(0, 0, At, B0); PG8_MMA(0, 1, At, B1); PG8_BAR; PG8_SCHED;
            PG8_LDA(At, 0, 1); PG8_STAGE(PG8_SB(0, 0), b2, voffB); PG8_STAGE(PG8_SB(0, 1), b2 + hstep, voffB); PG8_STAGE(PG8_SA(0, 0), a2, voffA);
            PG8_WAIT_V(8); PG8_WAIT_L(0); PG8_BAR; PG8_MMA(1, 0, At, B0); PG8_MMA(1, 1, At, B1); PG8_BAR; PG8_SCHED;
            PG8_LDB(B0, 1, 0); PG8_LDB(B1, 1, 1); PG8_SCHED; PG8_LDA(At, 1, 0); PG8_STAGE(PG8_SA(0, 1), a2 + hstep, voffA);
            PG8_WAIT_V(8); PG8_WAIT_L(0); PG8_BAR; PG8_MMA(0, 0, At, B0); PG8_MMA(0, 1, At, B1); PG8_BAR; PG8_SCHED;
            PG8_LDA(At, 1, 1); PG8_STAGE(PG8_SB(1, 0), b3, voffB); PG8_STAGE(PG8_SB(1, 1), b3 + hstep, voffB); PG8_STAGE(PG8_SA(1, 0), a3, voffA);
            PG8_WAIT_V(8); PG8_WAIT_L(0); PG8_BAR; PG8_MMA(1, 0, At, B0); PG8_MMA(1, 1, At, B1); PG8_BAR; PG8_SCHED;
        }
        if constexpr (ALIGN_EPI) { if (wr == 0) PG8_BAR; }
        E(acc, cur, wr, wc, fr, fq);
        if (!has_next) break;
#pragma unroll
        for (int a = 0; a < 2; ++a)
#pragma unroll
            for (int b = 0; b < 2; ++b)
#pragma unroll
                for (int m = 0; m < 4; ++m)
#pragma unroll
                    for (int n = 0; n < 2; ++n) acc[a][b][m][n] = (f32x4){0.f, 0.f, 0.f, 0.f};
        cur = nxt; cA = nA; cB = nB; ++ui;
        if constexpr (ALIGN_EPI) { if (wr == 1) PG8_BAR; }
    }
    PG8_WAIT_V(0);
    if constexpr (!ALIGN_EPI) { if (wr == 0) PG8_BAR; }
    PG8_BAR;
#undef PG8_SA
#undef PG8_SB
#undef PG8_STAGE
#undef PG8_LDA
#undef PG8_LDB
#undef PG8_MMA
#undef PG8_WAIT_V
#undef PG8_WAIT_L
#undef PG8_BAR
#undef PG8_SCHED
#undef PG8_APTR
#undef PG8_BPTR
}
}

struct Params {
    const float* x; const float* meta; const float* norm_w; const float* w_in; const float* sinks; const float* mu; const float* w0; const float* w2;
    const float* a0; const float* a2; const float* k_k; const float* k_a; const float* r_k; const float* ln_w; const float* ln_b;
    const float* w_ba; const float* w_br; const float* w_out; const float* fnw;
    float* out; unsigned char* ws;
};

struct EpiP1 {
    static constexpr bool PERM = true;
    bf16_t *Q, *KV, *RKV, *WA; const float* rope;
    __device__ __forceinline__ void operator()(const f32x4 (&acc)[2][2][4][2], const pg8::Unit& u, int wr, int wc, int fr, int fq) const {
        asm volatile("" : "+v"(fr), "+v"(fq));
        const int pn = u.pn, row0 = u.pm * 256 + wr * 64 + fr, cl = wc * 32 + 8 * fq;
        if (pn <= 4) {
            const float sc = pn < 4 ? QSCALE : 1.f;
#pragma unroll
            for (int ai = 0; ai < 2; ++ai)
#pragma unroll
                for (int m = 0; m < 4; ++m) {
                    const int row = row0 + ai * 128 + m * 16;
                    const int pos = row < MREAL ? (row & (SEQ - 1)) + NMETA : row - MREAL;
                    const float* rp = rope + (size_t)pos * 64;
#pragma unroll
                    for (int bj = 0; bj < 2; ++bj) {
                        const int col = bj * 128 + cl;
                        f32x4 v0 = acc[ai][bj][m][0], v1 = acc[ai][bj][m][1];
                        u32x4 w;
                        if (pn == 4 && bj == 1) {
                            w.x = cvt_pk_bf16(v0[0], v0[1]); w.y = cvt_pk_bf16(v0[2], v0[3]); w.z = cvt_pk_bf16(v1[0], v1[1]); w.w = cvt_pk_bf16(v1[2], v1[3]);
                        } else {
                            const int i0 = (col & 63) >> 1;
                            const f32x4 c = *(const f32x4*)(rp + i0), s = *(const f32x4*)(rp + 32 + i0);
                            w.x = cvt_pk_bf16((v0[0] * c[0] - v0[1] * s[0]) * sc, (v0[1] * c[0] + v0[0] * s[0]) * sc);
                            w.y = cvt_pk_bf16((v0[2] * c[1] - v0[3] * s[1]) * sc, (v0[3] * c[1] + v0[2] * s[1]) * sc);
                            w.z = cvt_pk_bf16((v1[0] * c[2] - v1[1] * s[2]) * sc, (v1[1] * c[2] + v1[0] * s[2]) * sc);
                            w.w = cvt_pk_bf16((v1[2] * c[3] - v1[3] * s[3]) * sc, (v1[3] * c[3] + v1[2] * s[3]) * sc);
                        }
                        bf16_t* dst = pn < 4 ? Q + (size_t)row * 1024 + pn * 256 + col : KV + (size_t)row * 256 + col;
                        *(u32x4*)dst = w;
                    }
                }
        } else {
#pragma unroll
            for (int ai = 0; ai < 2; ++ai)
#pragma unroll
                for (int m = 0; m < 4; ++m) {
                    const int row = row0 + ai * 128 + m * 16;
#pragma unroll
                    for (int bj = 0; bj < 2; ++bj) {
                        const int col = bj * 128 + cl;
                        const f32x4 v0 = acc[ai][bj][m][0], v1 = acc[ai][bj][m][1];
                        u32x4 w; w.x = cvt_pk_bf16(v0[0], v0[1]); w.y = cvt_pk_bf16(v0[2], v0[3]); w.z = cvt_pk_bf16(v1[0], v1[1]); w.w = cvt_pk_bf16(v1[2], v1[3]);
                        if (pn < 17) *(u32x4*)(RKV + (size_t)row * 3072 + (pn - 5) * 256 + col) = w;
                        else if (bj == 0) *(u32x4*)(WA + (size_t)row * 128 + col) = w;
                    }
                }
        }
    }
};
struct EpiGate {
    static constexpr bool PERM = true;
    bf16_t *Q, *RW, *SG;
    __device__ __forceinline__ void operator()(const f32x4 (&acc)[2][2][4][2], const pg8::Unit& u, int wr, int wc, int fr, int fq) const {
        asm volatile("" : "+v"(fr), "+v"(fq));
        const int pn = u.pn, row0 = u.pm * 256 + wr * 64 + fr, cl = wc * 32 + 8 * fq;
#pragma unroll
        for (int ai = 0; ai < 2; ++ai)
#pragma unroll
            for (int m = 0; m < 4; ++m) {
                const int row = row0 + ai * 128 + m * 16;
#pragma unroll
                for (int bj = 0; bj < 2; ++bj) {
                    const int col = bj * 128 + cl;
                    const f32x4 v0 = acc[ai][bj][m][0], v1 = acc[ai][bj][m][1];
                    u32x4 w;
                    if (pn < 8) {
                        bf16_t* p = (pn < 4 ? Q + (size_t)row * 1024 + pn * 256 : RW + (size_t)row * 1024 + (pn - 4) * 256) + col;
                        const u32x4 a = *(const u32x4*)p;
                        w.x = cvt_pk_bf16(bflo(a.x) * siluf_(v0[0]), bfhi(a.x) * siluf_(v0[1]));
                        w.y = cvt_pk_bf16(bflo(a.y) * siluf_(v0[2]), bfhi(a.y) * siluf_(v0[3]));
                        w.z = cvt_pk_bf16(bflo(a.z) * siluf_(v1[0]), bfhi(a.z) * siluf_(v1[1]));
                        w.w = cvt_pk_bf16(bflo(a.w) * siluf_(v1[2]), bfhi(a.w) * siluf_(v1[3]));
                        *(u32x4*)p = w;
                    } else {
                        w.x = cvt_pk_bf16(sigmoidf_(v0[0]), sigmoidf_(v0[1])); w.y = cvt_pk_bf16(sigmoidf_(v0[2]), sigmoidf_(v0[3]));
                        w.z = cvt_pk_bf16(sigmoidf_(v1[0]), sigmoidf_(v1[1])); w.w = cvt_pk_bf16(sigmoidf_(v1[2]), sigmoidf_(v1[3]));
                        *(u32x4*)(SG + (size_t)row * 2048 + (pn - 8) * 256 + col) = w;
                    }
                }
                asm volatile("" ::: "memory");
            }
    }
};
struct EpiBranch {
    static constexpr bool PERM = true;
    bf16_t* MG; const bf16_t* SG;
    __device__ __forceinline__ void operator()(const f32x4 (&acc)[2][2][4][2], const pg8::Unit& u, int wr, int wc, int fr, int fq) const {
        asm volatile("" : "+v"(fr), "+v"(fq));
        const int pn = u.pn, pc = pn & 3, row0 = u.pm * 256 + wr * 64 + fr, cl = wc * 32 + 8 * fq;
#pragma unroll
        for (int ai = 0; ai < 2; ++ai)
#pragma unroll
            for (int m = 0; m < 4; ++m) {
                const int row = row0 + ai * 128 + m * 16;
#pragma unroll
                for (int bj = 0; bj < 2; ++bj) {
                    const int col = pc * 256 + bj * 128 + cl;
                    const f32x4 v0 = acc[ai][bj][m][0], v1 = acc[ai][bj][m][1];
                    const u32x4 s = *(const u32x4*)(SG + (size_t)row * 2048 + (pn >= 4 ? 1024 : 0) + col);
                    bf16_t* p = MG + (size_t)row * 1024 + col;
                    float o0 = bflo(s.x) * v0[0], o1 = bfhi(s.x) * v0[1], o2 = bflo(s.y) * v0[2], o3 = bfhi(s.y) * v0[3];
                    float o4 = bflo(s.z) * v1[0], o5 = bfhi(s.z) * v1[1], o6 = bflo(s.w) * v1[2], o7 = bfhi(s.w) * v1[3];
                    if (pn >= 4) { const u32x4 a = *(const u32x4*)p;
                        o0 += bflo(a.x); o1 += bfhi(a.x); o2 += bflo(a.y); o3 += bfhi(a.y); o4 += bflo(a.z); o5 += bfhi(a.z); o6 += bflo(a.w); o7 += bfhi(a.w); }
                    u32x4 w; w.x = cvt_pk_bf16(o0, o1); w.y = cvt_pk_bf16(o2, o3); w.z = cvt_pk_bf16(o4, o5); w.w = cvt_pk_bf16(o6, o7);
                    *(u32x4*)p = w;
                }
                asm volatile("" ::: "memory");
            }
    }
};
struct EpiOut {
    static constexpr bool PERM = false;
    const float* x; float* out; LAS float* rowss;
    __device__ __forceinline__ void operator()(const f32x4 (&acc)[2][2][4][2], const pg8::Unit& u, int wr, int wc, int fr, int fq) const {
        asm volatile("" : "+v"(fr), "+v"(fq));
        const int row0 = u.pm * 256 + wr * 64 + fr, col0 = u.pn * 256 + wc * 32 + 4 * fq;
#pragma unroll
        for (int ai = 0; ai < 2; ++ai)
#pragma unroll
            for (int m = 0; m < 4; ++m) {
                const size_t off = (size_t)(row0 + ai * 128 + m * 16) * 1024 + col0;
                float ss = 0.f;
#pragma unroll
                for (int bj = 0; bj < 2; ++bj)
#pragma unroll
                    for (int n = 0; n < 2; ++n) {
                        const f32x4 h = *(const f32x4*)(x + off + bj * 128 + n * 16) + acc[ai][bj][m][n];
                        ss += (h[0] * h[0] + h[1] * h[1]) + (h[2] * h[2] + h[3] * h[3]);
                        *(f32x4*)(out + off + bj * 128 + n * 16) = h;
                    }
                ss += __shfl_xor(ss, 16); ss += __shfl_xor(ss, 32);
                if (fq == 0) __hip_atomic_fetch_add(rowss + ai * 128 + wr * 64 + m * 16 + fr, ss, __ATOMIC_RELAXED, __HIP_MEMORY_SCOPE_WORKGROUP);
                asm volatile("" ::: "memory");
            }
    }
};

__device__ __forceinline__ int win_dest(int n) {
    if (n < 1152) { const int hh = n >> 6, d = n & 63; return (hh << 6) + 2 * (d & 31) + (d >> 5); }
    if (n < 1280) return n;
    if (n < 2304) return 4608 + (n - 1280);
    if (n < 5504) return 1280 + (n - 2304);
    if (n < 6528) return 5632 + (n - 5504);
    return 6656 + (n - 6528);
}
template <bool MAPPED>
__device__ __forceinline__ void p0_transpose_item(const float* W, int N, bf16_t* WT, LAS float* scr, int item, int lane) {
    const int nblk = N / 32, kb = item / nblk, nb = item % nblk, k0 = 64 * kb, n0 = 32 * nb;
#pragma unroll 8
    for (int i = 0; i < 32; ++i) { const int kk = 2 * i + (lane >> 5); scr[kk * 33 + (lane & 31)] = W[(size_t)(k0 + kk) * N + n0 + (lane & 31)]; }
    asm volatile("s_waitcnt lgkmcnt(0)" ::: "memory");
    const int c = lane & 7;
#pragma unroll
    for (int j = 0; j < 4; ++j) { const int n = (lane >> 3) + 8 * j; const LAS float* s = scr + (8 * c) * 33 + n;
        u32x4 o; o.x = cvt_pk_bf16(s[0 * 33], s[1 * 33]); o.y = cvt_pk_bf16(s[2 * 33], s[3 * 33]); o.z = cvt_pk_bf16(s[4 * 33], s[5 * 33]); o.w = cvt_pk_bf16(s[6 * 33], s[7 * 33]);
        const int dr = MAPPED ? win_dest(n0 + n) : n0 + n;
        *(u32x4*)(WT + (size_t)dr * 1024 + k0 + 8 * c) = o; }
    asm volatile("s_waitcnt lgkmcnt(0)" ::: "memory");
}
__device__ __forceinline__ void rms_row_to_bf16(const float* xrow, const float* nw, bf16_t* orow, int lane) {
    const f32x4* xr = (const f32x4*)xrow + lane; const f32x4* wr4 = (const f32x4*)nw + lane;
    f32x4 v[4]; float s = 0.f;
#pragma unroll
    for (int j = 0; j < 4; ++j) { v[j] = xr[64 * j]; s += (v[j][0] * v[j][0] + v[j][1] * v[j][1]) + (v[j][2] * v[j][2] + v[j][3] * v[j][3]); }
    const float rstd = 1.f / sqrtf(wave_sum(s) * (1.f / DM) + RMS_EPS);
    u32x2* o8 = (u32x2*)orow + lane;
#pragma unroll
    for (int j = 0; j < 4; ++j) { const f32x4 w = wr4[64 * j]; u32x2 o; o.x = cvt_pk_bf16(v[j][0] * rstd * w[0], v[j][1] * rstd * w[1]); o.y = cvt_pk_bf16(v[j][2] * rstd * w[2], v[j][3] * rstd * w[3]); o8[64 * j] = o; }
}
__device__ __forceinline__ void p0_prologue(const Params& P, LAS unsigned char* lds, int G) {
    const int tid = threadIdx.x, lane = tid & 63, wave = tid >> 6;
    LAS float* scr = (LAS float*)(lds + wave * 16384);
    const int gw = blockIdx.x * 8 + wave, NGW = G * 8;
    bf16_t* WinT = (bf16_t*)(P.ws + WS_WIN); bf16_t* WbT = (bf16_t*)(P.ws + WS_WB); bf16_t* WoT = (bf16_t*)(P.ws + WS_WOUT);
    constexpr int I_IN = 16 * (NIN_SRC / 32), I_SQ = 16 * 32;
    for (int it = gw; it < I_IN + 3 * I_SQ; it += NGW) {
        int r = it;
        if (r < I_IN) { p0_transpose_item<true>(P.w_in, NIN_SRC, WinT, scr, r, lane); continue; } r -= I_IN;
        if (r < I_SQ) { p0_transpose_item<false>(P.w_ba, 1024, WbT, scr, r, lane); continue; } r -= I_SQ;
        if (r < I_SQ) { p0_transpose_item<false>(P.w_br, 1024, WbT + (size_t)1024 * 1024, scr, r, lane); continue; } r -= I_SQ;
        p0_transpose_item<false>(P.w_out, 1024, WoT, scr, r, lane);
    }
    for (int i = blockIdx.x * 512 + tid; i < 16384; i += G * 512) *((u32x4*)(WinT + (size_t)4480 * 1024) + i) = (u32x4){0u, 0u, 0u, 0u};
    bf16_t* U = (bf16_t*)(P.ws + WS_U);
    for (int m = gw; m < MREAL + NMETA; m += NGW) {
        const float* src = m < MREAL ? P.x + (size_t)m * DM : P.meta + (size_t)(m - MREAL) * DM;
        rms_row_to_bf16(src, P.norm_w, U + (size_t)m * DM, lane);
    }
    float* rope = (float*)(P.ws + WS_ROPE);
    for (int i = blockIdx.x * 512 + tid; i < TT * 32; i += G * 512) {
        const int pos = i >> 5, k = i & 31;
        const double inv = exp(-9.210340371976184 * (double)k / 32.0);
        const double ang = (double)pos * inv;
        rope[pos * 64 + k] = (float)cos(ang); rope[pos * 64 + 32 + k] = (float)sin(ang);
    }
}

constexpr int KS_STRIDE = 144;
constexpr int VT_STRIDE = 520;
constexpr int ATT_KS = 0, ATT_VT = 256 * KS_STRIDE;
__device__ __forceinline__ int crow(int r, int hi) { return (r & 3) + 8 * (r >> 2) + 4 * hi; }
__device__ __forceinline__ void attn_unit(const Params& P, LAS unsigned char* lds, int unit) {
    int tid_ = threadIdx.x; asm volatile("" : "+v"(tid_));
    const int tid = tid_, lane = tid & 63, wid = tid >> 6, qc = lane & 31, hi = lane >> 5;
    const int g = unit & 1, qb = (unit >> 1) & 63, b = unit >> 7;
    bf16_t* Q = (bf16_t*)(P.ws + WS_Q); const bf16_t* KV = (const bf16_t*)(P.ws + WS_KV);
    const int rb = b * SEQ + qb * 128;
    __syncthreads();
#pragma unroll
    for (int i = 0; i < 4; ++i) {
        const int id = tid + 512 * i, c = id >> 3, ch = id & 7;
        int row; bool ok = true;
        if (c >= 128) row = rb + c - 128; else if (qb > 0) row = rb - 128 + c; else { ok = c >= 112; row = MREAL + c - 112; }
        u32x4 kq = (u32x4){0u, 0u, 0u, 0u}, vq = kq;
        if (ok) { kq = *(const u32x4*)(KV + (size_t)row * 256 + g * 64 + ch * 8); vq = *(const u32x4*)(KV + (size_t)row * 256 + 128 + g * 64 + ch * 8); }
        *(LAS u32x4*)(lds + ATT_KS + c * KS_STRIDE + ch * 16) = kq;
        LAS unsigned short* vt = (LAS unsigned short*)(lds + ATT_VT) + (ch * 8) * (VT_STRIDE / 2) + c;
        vt[0 * (VT_STRIDE / 2)] = (unsigned short)(vq.x & 0xffff); vt[1 * (VT_STRIDE / 2)] = (unsigned short)(vq.x >> 16);
        vt[2 * (VT_STRIDE / 2)] = (unsigned short)(vq.y & 0xffff); vt[3 * (VT_STRIDE / 2)] = (unsigned short)(vq.y >> 16);
        vt[4 * (VT_STRIDE / 2)] = (unsigned short)(vq.z & 0xffff); vt[5 * (VT_STRIDE / 2)] = (unsigned short)(vq.z >> 16);
        vt[6 * (VT_STRIDE / 2)] = (unsigned short)(vq.w & 0xffff); vt[7 * (VT_STRIDE / 2)] = (unsigned short)(vq.w >> 16);
    }
    __syncthreads();
    const int h = g * 8 + wid;
    const float sink2 = P.sinks[h] * LOG2E;
    for (int qt = 0; qt < 4; ++qt) {
        bf16_t* qrow = Q + (size_t)(rb + qt * 32 + qc) * 1024 + h * 64;
        bf16x8 qf[4];
#pragma unroll
        for (int s = 0; s < 4; ++s) qf[s] = *(const bf16x8*)(qrow + s * 16 + hi * 8);
        f32x16 sc[5];
#pragma unroll
        for (int jj = 0; jj < 5; ++jj) {
            sc[jj] = (f32x16){0.f};
            const LAS unsigned char* kp = lds + ATT_KS + (32 * (qt + jj) + qc) * KS_STRIDE + hi * 16;
#pragma unroll
            for (int s = 0; s < 4; ++s) { const bf16x8 kf = *(const LAS bf16x8*)(kp + s * 32); sc[jj] = __builtin_amdgcn_mfma_f32_32x32x16_bf16(kf, qf[s], sc[jj], 0, 0, 0); }
        }
        float mx = sink2;
#pragma unroll
        for (int jj = 0; jj < 5; ++jj)
#pragma unroll
            for (int r = 0; r < 16; ++r) {
                const int kr = crow(r, hi);
                bool ok = true;
                if (jj == 0) ok = kr >= qc + 1;
                if (jj == 4) ok = kr <= qc;
                if (qb == 0) ok = ok && (32 * (qt + jj) + kr >= 112);
                const float v = ok ? sc[jj][r] : -1e30f;
                sc[jj][r] = v; mx = fmaxf(mx, v);
            }
        { auto rr = __builtin_amdgcn_permlane32_swap(__float_as_uint(mx), __float_as_uint(mx), false, false); mx = fmaxf(__uint_as_float(rr[0]), __uint_as_float(rr[1])); }
        float l = 0.f;
#pragma unroll
        for (int jj = 0; jj < 5; ++jj)
#pragma unroll
            for (int r = 0; r < 16; ++r) { const float p = __builtin_amdgcn_exp2f(sc[jj][r] - mx); sc[jj][r] = p; l += p; }
        { auto rr = __builtin_amdgcn_permlane32_swap(__float_as_uint(l), __float_as_uint(l), false, false); l = __uint_as_float(rr[0]) + __uint_as_float(rr[1]); }
        l += __builtin_amdgcn_exp2f(sink2 - mx);
        const float rl = 1.f / l;
        f32x16 o[2]; o[0] = (f32x16){0.f}; o[1] = (f32x16){0.f};
#pragma unroll
        for (int jj = 0; jj < 5; ++jj)
#pragma unroll
            for (int t = 0; t < 2; ++t) {
                u32x4 pw; pw.x = cvt_pk_bf16(sc[jj][8 * t + 0], sc[jj][8 * t + 1]); pw.y = cvt_pk_bf16(sc[jj][8 * t + 2], sc[jj][8 * t + 3]);
                pw.z = cvt_pk_bf16(sc[jj][8 * t + 4], sc[jj][8 * t + 5]); pw.w = cvt_pk_bf16(sc[jj][8 * t + 6], sc[jj][8 * t + 7]);
                const bf16x8 pf = __builtin_bit_cast(bf16x8, pw);
#pragma unroll
                for (int dt = 0; dt < 2; ++dt) {
                    const LAS unsigned char* vp = lds + ATT_VT + (32 * dt + qc) * VT_STRIDE + (32 * (qt + jj) + 16 * t + 4 * hi) * 2;
                    const u32x2 lo = *(const LAS u32x2*)vp, hi2 = *(const LAS u32x2*)(vp + 16);
                    const u32x4 vw = (u32x4){lo.x, lo.y, hi2.x, hi2.y};
                    o[dt] = __builtin_amdgcn_mfma_f32_32x32x16_bf16(__builtin_bit_cast(bf16x8, vw), pf, o[dt], 0, 0, 0);
                }
            }
#pragma unroll
        for (int dt = 0; dt < 2; ++dt)
#pragma unroll
            for (int rq = 0; rq < 4; ++rq) {
                u32x2 w; w.x = cvt_pk_bf16(o[dt][4 * rq + 0] * rl, o[dt][4 * rq + 1] * rl); w.y = cvt_pk_bf16(o[dt][4 * rq + 2] * rl, o[dt][4 * rq + 3] * rl);
                *(u32x2*)(qrow + 32 * dt + 8 * rq + 4 * hi) = w;
            }
    }
}

constexpr int TC = 32;
constexpr int SC_W2 = 0, SC_A2 = 16384, SC_TW = 32768, SC_ZAL = 40960, SC_R = 49152, SC_W = 57344, SC_K = 65536, SC_A = 73728, SC_B = 81920, SC_V = 90112, SC_Y = 98304, SC_BON = 106496;
__device__ __forceinline__ void scan_item(const Params& P, LAS unsigned char* lds, int item) {
    const int tid = threadIdx.x, lane = tid & 63, wid = tid >> 6;
    const int b = item >> 4, h = item & 15, hj = h * 64 + lane;
    const bf16_t* RKV = (const bf16_t*)(P.ws + WS_RKV); const bf16_t* WA = (const bf16_t*)(P.ws + WS_WA); bf16_t* RW = (bf16_t*)(P.ws + WS_RW);
    LAS float* w2s = (LAS float*)(lds + SC_W2); LAS float* a2s = (LAS float*)(lds + SC_A2); LAS float* tw = (LAS float*)(lds + SC_TW); LAS float* zal = (LAS float*)(lds + SC_ZAL);
    LAS float* Rs = (LAS float*)(lds + SC_R); LAS float* Ws = (LAS float*)(lds + SC_W); LAS float* Ks = (LAS float*)(lds + SC_K); LAS float* As = (LAS float*)(lds + SC_A);
    LAS float* Bs = (LAS float*)(lds + SC_B); LAS float* Vs = (LAS float*)(lds + SC_V); LAS float* Ys = (LAS float*)(lds + SC_Y); LAS float* BON = (LAS float*)(lds + SC_BON);
    __syncthreads();
    for (int i = tid; i < 4096; i += 512) { const int r = i >> 6, c = i & 63; w2s[i] = P.w2[(size_t)r * 1024 + h * 64 + c]; a2s[i] = P.a2[(size_t)r * 1024 + h * 64 + c]; }
    const float mu_r = P.mu[hj], mu_k = P.mu[1024 + hj], mu_v = P.mu[2048 + hj], mu_wl = P.mu[3072 + lane], mu_al = P.mu[3136 + lane];
    const float w0v = P.w0[hj], a0v = P.a0[hj], kkv = P.k_k[hj], kav = P.k_a[hj], rkv = P.r_k[hj], lnw = P.ln_w[hj], lnb = P.ln_b[hj];
    float S[8];
#pragma unroll
    for (int c = 0; c < 8; ++c) S[c] = 0.f;
    const int srow = tid >> 3, scg = tid & 7;
    for (int t0 = 0; t0 < TT; t0 += TC) {
        const int nt = (TT - t0) < TC ? (TT - t0) : TC;
        float zr[4], zk[4], zv[4];
        {
            float pr = 0.f, pk = 0.f, pv = 0.f, pwl = 0.f, pal = 0.f;
            const int tp = t0 + 4 * wid - 1;
            if (tp >= 0 && tp < TT) { const size_t row = tp < NMETA ? (size_t)MREAL + tp : (size_t)b * SEQ + tp - NMETA;
                pr = bf2f(RKV[row * 3072 + hj]); pk = bf2f(RKV[row * 3072 + 1024 + hj]); pv = bf2f(RKV[row * 3072 + 2048 + hj]); pwl = bf2f(WA[row * 128 + lane]); pal = bf2f(WA[row * 128 + 64 + lane]); }
#pragma unroll
            for (int q = 0; q < 4; ++q) {
                const int tl = 4 * wid + q, tk = t0 + tl;
                float cr = 0.f, ck = 0.f, cv = 0.f, cwl = 0.f, cal = 0.f;
                if (tk < TT) { const size_t row = tk < NMETA ? (size_t)MREAL + tk : (size_t)b * SEQ + tk - NMETA;
                    cr = bf2f(RKV[row * 3072 + hj]); ck = bf2f(RKV[row * 3072 + 1024 + hj]); cv = bf2f(RKV[row * 3072 + 2048 + hj]); cwl = bf2f(WA[row * 128 + lane]); cal = bf2f(WA[row * 128 + 64 + lane]); }
                zr[q] = cr + (pr - cr) * mu_r; zk[q] = ck + (pk - ck) * mu_k; zv[q] = cv + (pv - cv) * mu_v;
                tw[tl * 64 + lane] = tanhf(cwl + (pwl - cwl) * mu_wl); zal[tl * 64 + lane] = cal + (pal - cal) * mu_al;
                pr = cr; pk = ck; pv = cv; pwl = cwl; pal = cal;
            }
        }
        __syncthreads();
        float aw[4], aa[4];
#pragma unroll
        for (int q = 0; q < 4; ++q) { aw[q] = w0v; aa[q] = a0v; }
        for (int i = 0; i < 64; ++i) {
            const float wv = w2s[i * 64 + lane], av = a2s[i * 64 + lane];
#pragma unroll
            for (int q = 0; q < 4; ++q) { aw[q] += tw[(4 * wid + q) * 64 + i] * wv; aa[q] += zal[(4 * wid + q) * 64 + i] * av; }
        }
#pragma unroll
        for (int q = 0; q < 4; ++q) {
            const int tl = 4 * wid + q;
            const float y = -aw[q];
            const float sp = fmaxf(y, 0.f) + log1pf(expf(-fabsf(y)));
            const float wlog = -sp - 0.5f;
            const float decay = expf(-expf(wlog));
            const float a = 1.f / (1.f + expf(-aa[q]));
            float kk = zk[q] * kkv;
            const float n2 = wave_sum(kk * kk);
            kk = kk / fmaxf(sqrtf(n2), 1e-12f);
            const float kp = zk[q] * (1.f + (a - 1.f) * kav);
            const float bon = wave_sum(zr[q] * kp * rkv);
            Rs[tl * 64 + lane] = zr[q]; Ws[tl * 64 + lane] = decay; Ks[tl * 64 + lane] = kp; As[tl * 64 + lane] = -kk; Bs[tl * 64 + lane] = kk * a; Vs[tl * 64 + lane] = zv[q];
            if (lane == 0) BON[tl] = bon;
        }
        __syncthreads();
        for (int t = 0; t < nt; ++t) {
            const f32x4 w_0 = *(const LAS f32x4*)(Ws + t * 64 + 8 * scg), w_1 = *(const LAS f32x4*)(Ws + t * 64 + 8 * scg + 4);
            const f32x4 a_0 = *(const LAS f32x4*)(As + t * 64 + 8 * scg), a_1 = *(const LAS f32x4*)(As + t * 64 + 8 * scg + 4);
            const f32x4 b_0 = *(const LAS f32x4*)(Bs + t * 64 + 8 * scg), b_1 = *(const LAS f32x4*)(Bs + t * 64 + 8 * scg + 4);
            const f32x4 k_0 = *(const LAS f32x4*)(Ks + t * 64 + 8 * scg), k_1 = *(const LAS f32x4*)(Ks + t * 64 + 8 * scg + 4);
            const f32x4 r_0 = *(const LAS f32x4*)(Rs + t * 64 + 8 * scg), r_1 = *(const LAS f32x4*)(Rs + t * 64 + 8 * scg + 4);
            const float v = Vs[t * 64 + srow];
            float sa = (S[0] * a_0[0] + S[1] * a_0[1]) + (S[2] * a_0[2] + S[3] * a_0[3]) + (S[4] * a_1[0] + S[5] * a_1[1]) + (S[6] * a_1[2] + S[7] * a_1[3]);
            sa = red8(sa);
#pragma unroll
            for (int c = 0; c < 4; ++c) { S[c] = S[c] * w_0[c] + sa * b_0[c] + v * k_0[c]; S[4 + c] = S[4 + c] * w_1[c] + sa * b_1[c] + v * k_1[c]; }
            float y = (S[0] * r_0[0] + S[1] * r_0[1]) + (S[2] * r_0[2] + S[3] * r_0[3]) + (S[4] * r_1[0] + S[5] * r_1[1]) + (S[6] * r_1[2] + S[7] * r_1[3]);
            y = red8(y);
            if (scg == 0) Ys[t * 64 + srow] = y;
        }
        __syncthreads();
#pragma unroll
        for (int q = 0; q < 4; ++q) {
            const int tl = 4 * wid + q, tk = t0 + tl;
            const float y = Ys[tl * 64 + lane];
            const float mean = wave_sum(y) * (1.f / 64.f);
            const float d = y - mean;
            const float var = wave_sum(d * d) * (1.f / 64.f);
            const float o = d * (1.f / sqrtf(var + GN_EPS)) * lnw + lnb + BON[tl] * Vs[tl * 64 + lane];
            if (tl < nt && tk >= NMETA) RW[((size_t)b * SEQ + tk - NMETA) * 1024 + hj] = f2bf(o);
        }
        __syncthreads();
    }
}

constexpr int CH = 16, NCHUNK = TT / CH;
constexpr int IMG_STRIDE = 144;
constexpr int SL_IMG_A = 0, SL_IMG_R = 2304, SL_IMG_B = 4608, SL_IMG_K = 6912, SL_IMG_V = 9216, SL_NAK = 11520, SL_TT = 12032, SL_MT = 12544, SL_GAM = 13568, SL_BON = 13824, SLOT_BYTES = 13888;
constexpr int SCR_STRIDE = 272;
constexpr int SL_SCR_W = 0, SL_SCR_A = 16 * SCR_STRIDE;
constexpr int NSLOT = 8;
constexpr int CS_W2IMG = NSLOT * SLOT_BYTES, CS_A2IMG = CS_W2IMG + 8192, CS_CONST = CS_A2IMG + 8192, CS_FLAGS = CS_CONST + 12 * 256, CS_PART = CS_FLAGS + 64, CS_END = CS_PART + 512;
static_assert(CS_END <= 144 * 1024, "scan LDS map");
enum { CK_MU_R = 0, CK_MU_K, CK_MU_V, CK_MU_WL, CK_MU_AL, CK_W0, CK_A0, CK_KK, CK_KA, CK_RK, CK_LNW, CK_LNB };
typedef short v4i16 __attribute__((ext_vector_type(4)));
__device__ __forceinline__ u32x2 lds_tr16(const LAS unsigned char* p) { return __builtin_bit_cast(u32x2, __builtin_amdgcn_ds_read_tr16_b64_v4i16((LAS v4i16*)p)); }
__device__ __forceinline__ void lds_wait_ge(LAS unsigned char* p, int v) { while (*(volatile LAS int*)p < v) __builtin_amdgcn_s_sleep(1); asm volatile("" ::: "memory"); }
__device__ __forceinline__ void lds_flag_set(LAS unsigned char* p, int v, int lane) { asm volatile("s_waitcnt lgkmcnt(0)" ::: "memory"); if (lane == 0) *(volatile LAS int*)p = v; asm volatile("" ::: "memory"); }
__device__ __forceinline__ bf16x8 mk_frag(u32x2 lo, u32x2 hi) { return __builtin_bit_cast(bf16x8, (u32x4){lo.x, lo.y, hi.x, hi.y}); }
__device__ __forceinline__ u32x2 pk4(f32x4 v) { return (u32x2){cvt_pk_bf16(v[0], v[1]), cvt_pk_bf16(v[2], v[3])}; }
__device__ __forceinline__ void unpack8(u32x4 w, float* f) { f[0] = bflo(w.x); f[1] = bfhi(w.x); f[2] = bflo(w.y); f[3] = bfhi(w.y); f[4] = bflo(w.z); f[5] = bfhi(w.z); f[6] = bflo(w.w); f[7] = bfhi(w.w); }
__device__ __forceinline__ u32x4 pack8(const float* f) { return (u32x4){cvt_pk_bf16(f[0], f[1]), cvt_pk_bf16(f[2], f[3]), cvt_pk_bf16(f[4], f[5]), cvt_pk_bf16(f[6], f[7])}; }
__device__ __forceinline__ float red16(float v) {
    v += dppf<0xB1>(v); v += dppf<0x4E>(v); v += dppf<0x141>(v); v += dppf<0x140>(v); return v;
}
__device__ __forceinline__ float scan16(float v) {
    v += dppf<0x111>(v); v += dppf<0x112>(v); v += dppf<0x114>(v); v += dppf<0x118>(v); return v;
}
__device__ __forceinline__ float shr1_fill1(float v) {
    return __builtin_bit_cast(float, __builtin_amdgcn_update_dpp(0x3f800000, __builtin_bit_cast(int, v), 0x111, 0xF, 0xF, false));
}
#define MFMA32(a, b, c) __builtin_amdgcn_mfma_f32_16x16x32_bf16((a), (b), (c), 0, 0, 0)

__device__ __forceinline__ size_t scan_row(int b, int tau) { return tau < NMETA ? (size_t)MREAL + tau : (size_t)b * SEQ + (tau - NMETA); }

__device__ __forceinline__ void scan_producer(const Params& P, LAS unsigned char* lds, int b, int h, int pidx, int lane) {
    const int t = lane & 15, g = lane >> 4;
    const bf16_t* RKV = (const bf16_t*)(P.ws + WS_RKV); const bf16_t* WA = (const bf16_t*)(P.ws + WS_WA);
    const LAS unsigned char* cst = lds + CS_CONST;
    const f32x4 fzero = (f32x4){0.f, 0.f, 0.f, 0.f};
    u32x4 raw_wa[2][2][2];
#define ISSUE_WA(cc) do { const int tau_ = 16 * (cc) + t; const size_t rc_ = scan_row(b, tau_), rp_ = scan_row(b, tau_ > 0 ? tau_ - 1 : 0); \
        _Pragma("unroll") for (int s_ = 0; s_ < 2; ++s_) _Pragma("unroll") for (int a_ = 0; a_ < 2; ++a_) { \
            raw_wa[a_][0][s_] = *(const u32x4*)(WA + rc_ * 128 + a_ * 64 + 32 * s_ + 8 * g); raw_wa[a_][1][s_] = *(const u32x4*)(WA + rp_ * 128 + a_ * 64 + 32 * s_ + 8 * g); } } while (0)
#define CROW(k, off) (*(const LAS f32x4*)(cst + (k) * 256 + (off)))
    ISSUE_WA(pidx);
    for (int c = pidx; c < NCHUNK; c += 6) {
        LAS unsigned char* slot = lds + (c & (NSLOT - 1)) * SLOT_BYTES;
        const float pvalid = (16 * c + t > 0) ? 1.f : 0.f;
        u32x4 raw_rkv[3][2][2];
        { const int tau_ = 16 * c + t; const size_t rc_ = scan_row(b, tau_), rp_ = scan_row(b, tau_ > 0 ? tau_ - 1 : 0);
#pragma unroll
          for (int s_ = 0; s_ < 2; ++s_)
#pragma unroll
            for (int a_ = 0; a_ < 3; ++a_) { raw_rkv[a_][0][s_] = *(const u32x4*)(RKV + rc_ * 3072 + a_ * 1024 + h * 64 + 32 * s_ + 8 * g); raw_rkv[a_][1][s_] = *(const u32x4*)(RKV + rp_ * 3072 + a_ * 1024 + h * 64 + 32 * s_ + 8 * g); } }
        bf16x8 twf[2], alf[2];
#pragma unroll
        for (int s = 0; s < 2; ++s) {
            float cu[8], pr[8], z[8];
            const int co = (32 * s + 8 * g) * 4;
            const f32x4 m0 = CROW(CK_MU_WL, co), m1 = CROW(CK_MU_WL, co + 16);
            unpack8(raw_wa[0][0][s], cu); unpack8(raw_wa[0][1][s], pr);
#pragma unroll
            for (int e = 0; e < 8; ++e) { const float zz = cu[e] + (pr[e] * pvalid - cu[e]) * (e < 4 ? m0[e] : m1[e - 4]); const float ex = __builtin_amdgcn_exp2f(zz * (2.f * LOG2E)); z[e] = 1.f - 2.f * __builtin_amdgcn_rcpf(1.f + ex); }
            twf[s] = __builtin_bit_cast(bf16x8, pack8(z));
            const f32x4 n0 = CROW(CK_MU_AL, co), n1 = CROW(CK_MU_AL, co + 16);
            unpack8(raw_wa[1][0][s], cu); unpack8(raw_wa[1][1][s], pr);
#pragma unroll
            for (int e = 0; e < 8; ++e) z[e] = cu[e] + (pr[e] * pvalid - cu[e]) * (e < 4 ? n0[e] : n1[e - 4]);
            alf[s] = __builtin_bit_cast(bf16x8, pack8(z));
        }
        if (c + 6 < NCHUNK) ISSUE_WA(c + 6);
        f32x4 accw[4], acca[4];
#pragma unroll
        for (int nt = 0; nt < 4; ++nt) { accw[nt] = fzero; acca[nt] = fzero;
#pragma unroll
            for (int s = 0; s < 2; ++s) {
                accw[nt] = MFMA32(twf[s], *(const LAS bf16x8*)(lds + CS_W2IMG + ((s * 4 + nt) * 64 + lane) * 16), accw[nt]);
                acca[nt] = MFMA32(alf[s], *(const LAS bf16x8*)(lds + CS_A2IMG + ((s * 4 + nt) * 64 + lane) * 16), acca[nt]);
            } }
        if (c >= NSLOT) { lds_wait_ge(lds + CS_FLAGS + 32, c - NSLOT + 1); lds_wait_ge(lds + CS_FLAGS + 36, c - NSLOT + 1); }
#pragma unroll
        for (int nt = 0; nt < 4; ++nt)
#pragma unroll
            for (int r = 0; r < 4; ++r) {
                *(LAS float*)(slot + SL_SCR_W + (4 * g + r) * SCR_STRIDE + (16 * nt + t) * 4) = accw[nt][r];
                *(LAS float*)(slot + SL_SCR_A + (4 * g + r) * SCR_STRIDE + (16 * nt + t) * 4) = acca[nt][r];
            }
        asm volatile("s_waitcnt lgkmcnt(0)" ::: "memory");
        float wr[16], ar[16];
#pragma unroll
        for (int s = 0; s < 2; ++s)
#pragma unroll
            for (int q = 0; q < 2; ++q) {
                const f32x4 a = *(const LAS f32x4*)(slot + SL_SCR_W + t * SCR_STRIDE + (32 * s + 8 * g + 4 * q) * 4), bq = *(const LAS f32x4*)(slot + SL_SCR_A + t * SCR_STRIDE + (32 * s + 8 * g + 4 * q) * 4);
#pragma unroll
                for (int e = 0; e < 4; ++e) { wr[8 * s + 4 * q + e] = a[e]; ar[8 * s + 4 * q + e] = bq[e]; }
            }
        asm volatile("s_waitcnt lgkmcnt(0)" ::: "memory");
        __builtin_amdgcn_sched_barrier(0);
        float zr[16], zk[16];
#pragma unroll
        for (int s = 0; s < 2; ++s) {
            float cu[8], pr[8], z[8];
            const int co = (32 * s + 8 * g) * 4;
            const f32x4 r0 = CROW(CK_MU_R, co), r1 = CROW(CK_MU_R, co + 16);
            unpack8(raw_rkv[0][0][s], cu); unpack8(raw_rkv[0][1][s], pr);
#pragma unroll
            for (int e = 0; e < 8; ++e) zr[8 * s + e] = cu[e] + (pr[e] * pvalid - cu[e]) * (e < 4 ? r0[e] : r1[e - 4]);
            const f32x4 k0 = CROW(CK_MU_K, co), k1 = CROW(CK_MU_K, co + 16);
            unpack8(raw_rkv[1][0][s], cu); unpack8(raw_rkv[1][1][s], pr);
#pragma unroll
            for (int e = 0; e < 8; ++e) zk[8 * s + e] = cu[e] + (pr[e] * pvalid - cu[e]) * (e < 4 ? k0[e] : k1[e - 4]);
            const f32x4 v0 = CROW(CK_MU_V, co), v1 = CROW(CK_MU_V, co + 16);
            unpack8(raw_rkv[2][0][s], cu); unpack8(raw_rkv[2][1][s], pr);
#pragma unroll
            for (int e = 0; e < 8; ++e) z[e] = cu[e] + (pr[e] * pvalid - cu[e]) * (e < 4 ? v0[e] : v1[e - 4]);
            *(LAS u32x4*)(slot + SL_IMG_V + t * IMG_STRIDE + (32 * s + 8 * g) * 2) = pack8(z);
        }
        __builtin_amdgcn_sched_barrier(0);
        float ss = 0.f, bon = 0.f; float av[16];
#pragma unroll
        for (int s = 0; s < 2; ++s)
#pragma unroll
            for (int q = 0; q < 2; ++q) {
                const int co = (32 * s + 8 * g + 4 * q) * 4;
                const f32x4 c_a0 = CROW(CK_A0, co), c_kk = CROW(CK_KK, co), c_ka = CROW(CK_KA, co), c_rk = CROW(CK_RK, co);
#pragma unroll
                for (int e = 0; e < 4; ++e) { const int i = 8 * s + 4 * q + e;
                    const float a = sigmoidf_(c_a0[e] + ar[i]); av[i] = a;
                    const float kr_ = zk[i] * c_kk[e]; ss += kr_ * kr_;
                    bon += zr[i] * (zk[i] * (1.f + (a - 1.f) * c_ka[e])) * c_rk[e]; }
            }
        ss += __shfl_xor(ss, 16); ss += __shfl_xor(ss, 32); bon += __shfl_xor(bon, 16); bon += __shfl_xor(bon, 32);
        const float inv = 1.f / fmaxf(sqrtf(ss), 1e-12f);
        if (g == 0) *(LAS float*)(slot + SL_BON + t * 4) = bon;
        __builtin_amdgcn_sched_barrier(0);
        bf16x8 Af[2], Rf[2], Bf[2], Kf[2];
#pragma unroll
        for (int s = 0; s < 2; ++s) {
            float fa[8], fr_[8], fb[8], fk[8], gam[8];
#pragma unroll
            for (int q = 0; q < 2; ++q) {
                const int co = (32 * s + 8 * g + 4 * q) * 4;
                const f32x4 c_w0 = CROW(CK_W0, co), c_kk = CROW(CK_KK, co), c_ka = CROW(CK_KA, co);
#pragma unroll
                for (int e = 0; e < 4; ++e) { const int i = 8 * s + 4 * q + e, j = 4 * q + e;
                    const float lw = -0.6065306597126334f * sigmoidf_(c_w0[e] + wr[i]);
                    const float L = scan16(lw);
                    const float eL = __builtin_amdgcn_exp2f(L * LOG2E), ieL = __builtin_amdgcn_rcpf(eL), eLm = shr1_fill1(eL);
                    const float kk = zk[i] * c_kk[e] * inv, kp = zk[i] * (1.f + (av[i] - 1.f) * c_ka[e]);
                    fa[j] = -kk * eLm; fb[j] = kk * av[i] * ieL; fk[j] = kp * ieL; fr_[j] = zr[i] * eL; gam[j] = eL; }
            }
            const u32x4 pa = pack8(fa), pr = pack8(fr_), pb = pack8(fb), pk = pack8(fk);
            Af[s] = __builtin_bit_cast(bf16x8, pa); Rf[s] = __builtin_bit_cast(bf16x8, pr); Bf[s] = __builtin_bit_cast(bf16x8, pb); Kf[s] = __builtin_bit_cast(bf16x8, pk);
            const int off = t * IMG_STRIDE + (32 * s + 8 * g) * 2;
            *(LAS u32x4*)(slot + SL_IMG_A + off) = pa; *(LAS u32x4*)(slot + SL_IMG_R + off) = pr; *(LAS u32x4*)(slot + SL_IMG_B + off) = pb; *(LAS u32x4*)(slot + SL_IMG_K + off) = pk;
            if (t == 15) { *(LAS f32x4*)(slot + SL_GAM + (32 * s + 8 * g) * 4) = (f32x4){gam[0], gam[1], gam[2], gam[3]}; *(LAS f32x4*)(slot + SL_GAM + (32 * s + 8 * g + 4) * 4) = (f32x4){gam[4], gam[5], gam[6], gam[7]}; }
            __builtin_amdgcn_sched_barrier(0);
        }
        f32x4 nab = MFMA32(Bf[0], Af[0], fzero), nabT = MFMA32(Af[0], Bf[0], fzero), nak = MFMA32(Kf[0], Af[0], fzero), mbr = MFMA32(Bf[0], Rf[0], fzero), mkr = MFMA32(Kf[0], Rf[0], fzero);
        nab = MFMA32(Bf[1], Af[1], nab); nabT = MFMA32(Af[1], Bf[1], nabT); nak = MFMA32(Kf[1], Af[1], nak); mbr = MFMA32(Bf[1], Rf[1], mbr); mkr = MFMA32(Kf[1], Rf[1], mkr);
#pragma unroll
        for (int r = 0; r < 4; ++r) { const int s_ = 4 * g + r;
            if (!(s_ < t)) { nab[r] = 0.f; nak[r] = 0.f; }
            if (!(s_ <= t)) { mbr[r] = 0.f; mkr[r] = 0.f; }
            if (!(t < s_)) nabT[r] = 0.f; }
        const u32x2 z2 = (u32x2){0u, 0u};
#define FRG(x) mk_frag(pk4(x), z2)
        const bf16x8 fN = FRG(nab), fNT = FRG(nabT);
        const f32x4 n2 = MFMA32(fNT, fN, fzero), n2T = MFMA32(fN, fNT, fzero);
        const bf16x8 fN2 = FRG(n2), fN2T = FRG(n2T);
        const f32x4 n4 = MFMA32(fN2T, fN2, fzero), n4T = MFMA32(fN2, fN2T, fzero);
        const bf16x8 fN4 = FRG(n4), fN4T = FRG(n4T);
        const f32x4 n8T = MFMA32(fN4, fN4T, fzero);
        f32x4 q0 = nab;
#pragma unroll
        for (int r = 0; r < 4; ++r) if (4 * g + r == t) q0[r] += 1.f;
        const f32x4 q1 = MFMA32(fN2T, FRG(q0), q0);
        const f32x4 q2 = MFMA32(fN4T, FRG(q1), q1);
        const f32x4 tt = MFMA32(FRG(n8T), FRG(q2), q2);
#undef FRG
        *(LAS u32x2*)(slot + SL_NAK + lane * 8) = pk4(nak);
        *(LAS u32x2*)(slot + SL_TT + lane * 8) = pk4(tt);
        { const u32x2 a = pk4(mbr), bq = pk4(mkr); *(LAS u32x4*)(slot + SL_MT + lane * 16) = (u32x4){a.x, a.y, bq.x, bq.y}; }
        lds_flag_set(lds + CS_FLAGS + 4 * (c & (NSLOT - 1)), c + 1, lane);
    }
#undef ISSUE_WA
#undef CROW
}

__device__ __forceinline__ void scan_consumer(const Params& P, LAS unsigned char* lds, int b, int h, int wc, int lane) {
    const int i16 = lane & 15, g = lane >> 4;
    bf16_t* RW = (bf16_t*)(P.ws + WS_RW);
    const f32x4 fzero = (f32x4){0.f, 0.f, 0.f, 0.f};
    const u32x2 z2 = (u32x2){0u, 0u};
    f32x4 sacc[2][4];
#pragma unroll
    for (int n = 0; n < 2; ++n)
#pragma unroll
        for (int j = 0; j < 4; ++j) sacc[n][j] = fzero;
    float lnw[2], lnb[2];
#pragma unroll
    for (int n = 0; n < 2; ++n) { lnw[n] = *(const LAS float*)(lds + CS_CONST + CK_LNW * 256 + (16 * (2 * wc + n) + i16) * 4); lnb[n] = *(const LAS float*)(lds + CS_CONST + CK_LNB * 256 + (16 * (2 * wc + n) + i16) * 4); }
    __builtin_amdgcn_s_setprio(3);
    for (int c = 0; c < NCHUNK; ++c) {
        LAS unsigned char* slot = lds + (c & (NSLOT - 1)) * SLOT_BYTES;
        lds_wait_ge(lds + CS_FLAGS + 4 * (c & (NSLOT - 1)), c + 1);
        bf16x8 Af[2], Rf[2];
#pragma unroll
        for (int s = 0; s < 2; ++s) {
            const int off = i16 * IMG_STRIDE + (32 * s + 4 * g) * 2;
            Af[s] = mk_frag(*(const LAS u32x2*)(slot + SL_IMG_A + off), *(const LAS u32x2*)(slot + SL_IMG_A + off + 32));
            Rf[s] = mk_frag(*(const LAS u32x2*)(slot + SL_IMG_R + off), *(const LAS u32x2*)(slot + SL_IMG_R + off + 32));
        }
        const u32x2 nak = *(const LAS u32x2*)(slot + SL_NAK + lane * 8), ttf = *(const LAS u32x2*)(slot + SL_TT + lane * 8);
        const bf16x8 MTf = *(const LAS bf16x8*)(slot + SL_MT + lane * 16);
        const int troff = (4 * g + (i16 >> 2)) * IMG_STRIDE + (i16 & 3) * 8;
        bf16x8 BKf[4];
#pragma unroll
        for (int jt = 0; jt < 4; ++jt) BKf[jt] = mk_frag(lds_tr16(slot + SL_IMG_B + troff + jt * 32), lds_tr16(slot + SL_IMG_K + troff + jt * 32));
        u32x2 vt[2];
#pragma unroll
        for (int n = 0; n < 2; ++n) vt[n] = lds_tr16(slot + SL_IMG_V + troff + (2 * wc + n) * 32);
        f32x4 gm[4];
#pragma unroll
        for (int jt = 0; jt < 4; ++jt) gm[jt] = *(const LAS f32x4*)(slot + SL_GAM + (16 * jt + 4 * g) * 4);
        const f32x4 bonv = *(const LAS f32x4*)(slot + SL_BON + 16 * g);
        lds_flag_set(lds + CS_FLAGS + 32 + 4 * wc, c + 1, lane);
        f32x4 yacc[2];
#pragma unroll
        for (int n = 0; n < 2; ++n) {
            const bf16x8 S0 = mk_frag(pk4(sacc[n][0]), pk4(sacc[n][1])), S1 = mk_frag(pk4(sacc[n][2]), pk4(sacc[n][3]));
            f32x4 x = MFMA32(Af[0], S0, fzero); x = MFMA32(Af[1], S1, x); x = MFMA32(mk_frag(z2, nak), mk_frag(z2, vt[n]), x);
            const f32x4 u = MFMA32(mk_frag(ttf, z2), mk_frag(pk4(x), z2), fzero);
            const bf16x8 UV = mk_frag(pk4(u), vt[n]);
            f32x4 y = MFMA32(Rf[0], S0, fzero); y = MFMA32(Rf[1], S1, y); y = MFMA32(MTf, UV, y);
            yacc[n] = y;
#pragma unroll
            for (int jt = 0; jt < 4; ++jt) { const f32x4 sn = MFMA32(BKf[jt], UV, sacc[n][jt]); sacc[n][jt] = sn * gm[jt]; }
        }
        f32x4 ps = yacc[0] + yacc[1], pq = yacc[0] * yacc[0] + yacc[1] * yacc[1];
#pragma unroll
        for (int r = 0; r < 4; ++r) { ps[r] = red16(ps[r]); pq[r] = red16(pq[r]); }
        LAS unsigned char* part = lds + CS_PART;
        if (i16 == 0) { *(LAS f32x4*)(part + ((wc * 2 + (c & 1)) * 2 + 0) * 64 + 16 * g) = ps; *(LAS f32x4*)(part + ((wc * 2 + (c & 1)) * 2 + 1) * 64 + 16 * g) = pq; }
        lds_flag_set(lds + CS_FLAGS + 40 + 4 * wc, c + 1, lane);
        lds_wait_ge(lds + CS_FLAGS + 40 + 4 * (1 - wc), c + 1);
        const f32x4 os = *(const LAS f32x4*)(part + (((1 - wc) * 2 + (c & 1)) * 2 + 0) * 64 + 16 * g), oq = *(const LAS f32x4*)(part + (((1 - wc) * 2 + (c & 1)) * 2 + 1) * 64 + 16 * g);
        if (c >= 1) {
#pragma unroll
            for (int r = 0; r < 4; ++r) {
                const float mean = (ps[r] + os[r]) * (1.f / 64.f), var = fmaxf((pq[r] + oq[r]) * (1.f / 64.f) - mean * mean, 0.f), rstd = 1.f / sqrtf(var + GN_EPS);
                const size_t row = (size_t)b * SEQ + 16 * (c - 1) + 4 * g + r;
#pragma unroll
                for (int n = 0; n < 2; ++n) {
                    const unsigned vw = r < 2 ? vt[n].x : vt[n].y; const float v = (r & 1) ? bfhi(vw) : bflo(vw);
                    const float o = (yacc[n][r] - mean) * rstd * lnw[n] + lnb[n] + bonv[r] * v;
                    RW[row * 1024 + h * 64 + 16 * (2 * wc + n) + i16] = f2bf(o);
                }
            }
        }
    }
    __builtin_amdgcn_s_setprio(0);
}

__device__ __forceinline__ void scan_item_chunked(const Params& P, LAS unsigned char* lds, int item) {
    int tid_ = threadIdx.x; asm volatile("" : "+v"(tid_));
    const int tid = tid_, lane = tid & 63, wid = __builtin_amdgcn_readfirstlane(tid >> 6);
    const int b = item >> 4, h = item & 15;
    __syncthreads();
    {
        const int fs = tid >> 8, fnt = (tid >> 6) & 3, l = tid & 63;
        float f[8], f2[8];
#pragma unroll
        for (int e = 0; e < 8; ++e) { const size_t idx = (size_t)(32 * fs + 8 * (l >> 4) + e) * 1024 + h * 64 + 16 * fnt + (l & 15); f[e] = P.w2[idx]; f2[e] = P.a2[idx]; }
        *(LAS u32x4*)(lds + CS_W2IMG + tid * 16) = pack8(f); *(LAS u32x4*)(lds + CS_A2IMG + tid * 16) = pack8(f2);
    }
    if (tid < 64) {
        LAS float* cf = (LAS float*)(lds + CS_CONST); const int hj = h * 64 + tid;
        cf[CK_MU_R * 64 + tid] = P.mu[hj]; cf[CK_MU_K * 64 + tid] = P.mu[1024 + hj]; cf[CK_MU_V * 64 + tid] = P.mu[2048 + hj]; cf[CK_MU_WL * 64 + tid] = P.mu[3072 + tid]; cf[CK_MU_AL * 64 + tid] = P.mu[3136 + tid];
        cf[CK_W0 * 64 + tid] = P.w0[hj]; cf[CK_A0 * 64 + tid] = P.a0[hj]; cf[CK_KK * 64 + tid] = P.k_k[hj]; cf[CK_KA * 64 + tid] = P.k_a[hj]; cf[CK_RK * 64 + tid] = P.r_k[hj];
        cf[CK_LNW * 64 + tid] = P.ln_w[hj]; cf[CK_LNB * 64 + tid] = P.ln_b[hj];
        if (tid < 16) *(LAS int*)(lds + CS_FLAGS + 4 * tid) = 0;
    }
    __syncthreads();
    if (wid < 2) scan_consumer(P, lds, b, h, wid, lane);
    else scan_producer(P, lds, b, h, wid - 2, lane);
    __syncthreads();
}

__device__ __forceinline__ void chain_fence() {
    asm volatile("s_waitcnt vmcnt(0) lgkmcnt(0)" ::: "memory");
    __builtin_amdgcn_fence(__ATOMIC_SEQ_CST, "agent");
    asm volatile("s_waitcnt vmcnt(0)" ::: "memory");
    __syncthreads();
}
__device__ __forceinline__ void tail_tile(const Params& P, LAS unsigned char* lds, int pm) {
    const int tid = threadIdx.x, lane = tid & 63, wid = tid >> 6;
    bf16_t* U = (bf16_t*)(P.ws + WS_U); bf16_t* Q = (bf16_t*)(P.ws + WS_Q); bf16_t* RW = (bf16_t*)(P.ws + WS_RW);
    const bf16_t* WinT = (const bf16_t*)(P.ws + WS_WIN); const bf16_t* WbT = (const bf16_t*)(P.ws + WS_WB); const bf16_t* WoT = (const bf16_t*)(P.ws + WS_WOUT);
    bf16_t* SG = (bf16_t*)P.out;
    LAS float* rowss = (LAS float*)(lds + LDS_ROWSS);
    if (tid < 256) rowss[tid] = 0.f;
    if (PHASE_MASK & 0x10) {
        pg8::Gemm g{U, U, WinT + (size_t)NP1 * 1024, 1024, 1 << 30}; pg8::LocalOrder S{pm, 16}; EpiGate E{Q, RW, SG};
        pg8::gemm_phase<EpiGate, pg8::LocalOrder, true>(lds, g, S, E);
    }
    chain_fence();
    if (PHASE_MASK & 0x20) {
        pg8::Gemm g{Q, RW, WbT, 1024, 4}; pg8::LocalOrder S{pm, 8}; EpiBranch E{U, SG};
        pg8::gemm_phase<EpiBranch, pg8::LocalOrder, true>(lds, g, S, E);
    }
    chain_fence();
    if (PHASE_MASK & 0x40) {
        pg8::Gemm g{U, U, WoT, 1024, 1 << 30}; pg8::LocalOrder S{pm, 4}; EpiOut E{P.x, P.out, rowss};
        pg8::gemm_phase<EpiOut, pg8::LocalOrder, true>(lds, g, S, E);
    }
    chain_fence();
    for (int r = wid * 32; r < wid * 32 + 32; ++r) {
        const float rstd = 1.f / sqrtf(rowss[r] * (1.f / DM) + RMS_EPS);
        f32x4* o = (f32x4*)(P.out + (size_t)(pm * 256 + r) * 1024) + lane; const f32x4* fw = (const f32x4*)P.fnw + lane;
#pragma unroll
        for (int j = 0; j < 4; ++j) { const f32x4 v = o[64 * j], w = fw[64 * j]; o[64 * j] = (f32x4){v[0] * rstd * w[0], v[1] * rstd * w[1], v[2] * rstd * w[2], v[3] * rstd * w[3]}; }
    }
    __syncthreads();
}

__global__ void __launch_bounds__(512, 2) fwd_megakernel(Params P) {
    extern __shared__ __attribute__((aligned(16))) unsigned char lds_raw[];
    LAS unsigned char* lds = (LAS unsigned char*)lds_raw;
    cg::grid_group grid = cg::this_grid();
    const int G = gridDim.x;
    unsigned long long probe_wait = 0ull, probe_t0 = 0ull;
#define PROBE_BEGIN(k) do { if (PROBE_PHASE == (k)) probe_t0 = __builtin_amdgcn_s_memrealtime(); } while (0)
#define PROBE_END(k) do { if (PROBE_PHASE == (k)) probe_wait += __builtin_amdgcn_s_memrealtime() - probe_t0; } while (0)
    PROBE_BEGIN(0);
    if (PHASE_MASK & 1) p0_prologue(P, lds, G);
    PROBE_END(0);
    __builtin_amdgcn_fence(__ATOMIC_SEQ_CST, "agent"); grid.sync(); __builtin_amdgcn_fence(__ATOMIC_SEQ_CST, "agent");
    PROBE_BEGIN(1);
    if (PHASE_MASK & 2) {
        pg8::Gemm g{(const bf16_t*)(P.ws + WS_U), (const bf16_t*)(P.ws + WS_U), (const bf16_t*)(P.ws + WS_WIN), 1024, 1 << 30};
        pg8::StaticOrder S; S.init(MPAD, NP1, G, (int)blockIdx.x);
        EpiP1 E{(bf16_t*)(P.ws + WS_Q), (bf16_t*)(P.ws + WS_KV), (bf16_t*)(P.ws + WS_RKV), (bf16_t*)(P.ws + WS_WA), (const float*)(P.ws + WS_ROPE)};
        pg8::gemm_phase<EpiP1, pg8::StaticOrder, true>(lds, g, S, E);
    }
    PROBE_END(1);
    __builtin_amdgcn_fence(__ATOMIC_SEQ_CST, "agent"); grid.sync(); __builtin_amdgcn_fence(__ATOMIC_SEQ_CST, "agent");
    PROBE_BEGIN(2);
    if (G == 256) {
        if (blockIdx.x < 128) { if (PHASE_MASK & 4) scan_item_chunked(P, lds, blockIdx.x); }
        else { if (PHASE_MASK & 8) for (int u = blockIdx.x - 128; u < 1024; u += 128) attn_unit(P, lds, u); }
    } else {
        for (int it = blockIdx.x; it < 128 + 1024; it += G) { if (it < 128) { if (PHASE_MASK & 4) scan_item_chunked(P, lds, it); } else { if (PHASE_MASK & 8) attn_unit(P, lds, it - 128); } }
    }
    PROBE_END(2);
    __builtin_amdgcn_fence(__ATOMIC_SEQ_CST, "agent"); grid.sync(); __builtin_amdgcn_fence(__ATOMIC_SEQ_CST, "agent");
    PROBE_BEGIN(3);
    if (PHASE_MASK & 0xF0) for (int pm = blockIdx.x; pm < MREAL / 256; pm += G) tail_tile(P, lds, pm);
    PROBE_END(3);
    if (PROBE_PHASE >= 0 && blockIdx.x == PROBE_BLOCK && threadIdx.x == 0) {
        const unsigned long long t = __builtin_amdgcn_s_memrealtime();
        while (__builtin_amdgcn_s_memrealtime() - t < probe_wait) __builtin_amdgcn_s_sleep(8);
    }
}

extern "C" void kernel_launch(void* const* d_in, const int* in_sizes, int n_in, void* d_out, int out_size, void* d_ws, size_t ws_size, hipStream_t stream) {
    static int grid = 0;
    if (grid == 0) {
        if (n_in != 19 || in_sizes[0] != MREAL * DM || out_size != MREAL * DM || ws_size < WS_END) {
            fprintf(stderr, "kernel_launch: unexpected shapes (n_in %d, in0 %d, out %d, ws %zu); nothing launched\n", n_in, n_in > 0 ? in_sizes[0] : -1, out_size, ws_size); grid = -1; return; }
        int dev = 0, cus = 0, per_cu = 0;
        hipGetDevice(&dev);
        hipDeviceGetAttribute(&cus, hipDeviceAttributeMultiprocessorCount, dev);
        hipFuncSetAttribute((const void*)fwd_megakernel, hipFuncAttributeMaxDynamicSharedMemorySize, LDS_BYTES);
        hipOccupancyMaxActiveBlocksPerMultiprocessor(&per_cu, (const void*)fwd_megakernel, 512, LDS_BYTES);
        if (per_cu < 1) { fprintf(stderr, "kernel_launch: occupancy query says %d blocks per CU\n", per_cu); per_cu = 1; }
        grid = cus * 1;
        if (grid > 256) grid = 256;
        (void)hipGetLastError();
    }
    if (grid < 0) return;
    Params p{};
    p.x = (const float*)d_in[0]; p.meta = (const float*)d_in[1]; p.norm_w = (const float*)d_in[2]; p.w_in = (const float*)d_in[3]; p.sinks = (const float*)d_in[4];
    p.mu = (const float*)d_in[5]; p.w0 = (const float*)d_in[6]; p.w2 = (const float*)d_in[7]; p.a0 = (const float*)d_in[8]; p.a2 = (const float*)d_in[9];
    p.k_k = (const float*)d_in[10]; p.k_a = (const float*)d_in[11]; p.r_k = (const float*)d_in[12]; p.ln_w = (const float*)d_in[13]; p.ln_b = (const float*)d_in[14];
    p.w_ba = (const float*)d_in[15]; p.w_br = (const float*)d_in[16]; p.w_out = (const float*)d_in[17]; p.fnw = (const float*)d_in[18];
    p.out = (float*)d_out; p.ws = (unsigned char*)d_ws;
    void* args[] = {&p};
    hipError_t e = hipLaunchCooperativeKernel((const void*)fwd_megakernel, dim3(grid), dim3(512), args, LDS_BYTES, stream);
    if (e != hipSuccess) fprintf(stderr, "cooperative launch failed: %s (grid %d)\n", hipGetErrorString(e), grid);
}
```

```cpp
#include <hip/hip_runtime.h>
#include <hip/hip_cooperative_groups.h>
#include <cstdio>
#include <cstdint>
namespace cg = cooperative_groups;
#ifndef PROBE_PHASE
#define PROBE_PHASE -1
#endif
#ifndef PROBE_BLOCK
#define PROBE_BLOCK 0
#endif
#ifndef PHASE_MASK
#define PHASE_MASK 0xFF
#endif

#define LAS __attribute__((address_space(3)))
typedef unsigned short bf16_t;
typedef short bf16x8 __attribute__((ext_vector_type(8)));
typedef short s16x4 __attribute__((ext_vector_type(4)));
typedef float f32x4 __attribute__((ext_vector_type(4)));
typedef float f32x16 __attribute__((ext_vector_type(16)));
typedef unsigned u32x4 __attribute__((ext_vector_type(4)));
typedef unsigned u32x2 __attribute__((ext_vector_type(2)));

constexpr int DM = 1024, NB = 8, SEQ = 8192, NMETA = 16, TT = SEQ + NMETA;
constexpr int MREAL = NB * SEQ;
constexpr int MPAD = MREAL + 256;
constexpr int NIN_SRC = 8576, NIN = 8704;
constexpr int NP1 = 4608;
constexpr float RMS_EPS = 1e-6f, GN_EPS = 64e-5f;
constexpr float LOG2E = 1.4426950408889634f;
constexpr float QSCALE = 0.125f * LOG2E;

constexpr size_t MiB = 1u << 20;
constexpr size_t WS_CTL = 0, CTL_ZERO_BYTES = 1 * MiB;
constexpr size_t WS_ROWSS = 512 * 1024;
constexpr size_t WS_WIN = 1 * MiB;
constexpr size_t WS_WB = 18 * MiB;
constexpr size_t WS_WOUT = 22 * MiB;
constexpr size_t WS_ROPE = 24 * MiB;
constexpr size_t WS_U = 27 * MiB;
constexpr size_t WS_Q = 156 * MiB;
constexpr size_t WS_KV = 285 * MiB;
constexpr size_t WS_RKV = 318 * MiB;
constexpr size_t WS_WA = 704 * MiB;
constexpr size_t WS_RW = 721 * MiB;
constexpr size_t WS_END = 849 * MiB;

constexpr int LDS_STAGE = 131072;
constexpr int LDS_BARST = 155648 - 64;
constexpr int LDS_BYTES = 155648;

typedef float f32x2_t __attribute__((ext_vector_type(2))); typedef __bf16 bf16x2_t __attribute__((ext_vector_type(2)));
__device__ __forceinline__ unsigned cvt_pk_bf16(float lo, float hi) { const f32x2_t v = {lo, hi}; const bf16x2_t b = __builtin_convertvector(v, bf16x2_t); return __builtin_bit_cast(unsigned, b); }
__device__ __forceinline__ float bf2f(unsigned short b) { return __uint_as_float((unsigned)b << 16); }
__device__ __forceinline__ float bflo(unsigned w) { return __uint_as_float(w << 16); }
__device__ __forceinline__ float bfhi(unsigned w) { return __uint_as_float(w & 0xffff0000u); }
__device__ __forceinline__ unsigned short f2bf(float f) { return (unsigned short)(cvt_pk_bf16(f, 0.f) & 0xffffu); }
__device__ __forceinline__ float wave_sum(float v) {
#pragma unroll
    for (int o = 1; o < 64; o <<= 1) v += __shfl_xor(v, o);
    return v;
}
template <int CTRL> __device__ __forceinline__ float dppf(float v) {
    return __builtin_bit_cast(float, __builtin_amdgcn_update_dpp(0, __builtin_bit_cast(int, v), CTRL, 0xF, 0xF, true));
}
__device__ __forceinline__ float red8(float v) {
    v += dppf<0xB1>(v);
    v += dppf<0x4E>(v);
    v += dppf<0x141>(v);
    return v;
}
__device__ __forceinline__ float sigmoidf_(float x) { return __builtin_amdgcn_rcpf(1.f + __builtin_amdgcn_exp2f(-x * LOG2E)); }
__device__ __forceinline__ float siluf_(float x) { return x * sigmoidf_(x); }

namespace pg8 {
constexpr int BM = 256, BK = 64, HALF = 128, HTB = HALF * BK * 2, STAGE_BYTES = 8 * HTB, NXCD = 8, WGM = 8;
__host__ __device__ __forceinline__ int lds_byte(int r, int c) { const int st = (r >> 4) * 2 + (c >> 5), rr = r & 15, cc = c & 31, ob = rr * 64 + cc * 2; return st * 1024 + (ob ^ (((ob >> 9) & 1) << 5)); }
__host__ __device__ __forceinline__ void stage_rc(int b, int& R, int& C) { const int st = b / 1024, sb = b % 1024, swz = sb ^ (((sb >> 9) & 1) << 5); R = (st >> 1) * 16 + swz / 64; C = (st & 1) * 32 + (swz % 64) / 2; }
__host__ __device__ __forceinline__ int perm32(int rho) { const int n = rho >> 4, i = rho & 15; return 8 * (i >> 2) + 4 * n + (i & 3); }

struct Unit { int pm, pn; };
struct Gemm { const bf16_t* A; const bf16_t* A2; const bf16_t* Bt; int K; int asplit; };

struct StaticOrder {
    int nM, nN, nwg, G, c, L0, L1;
    __device__ void init(int M, int N, int G_, int c_) { nM = M / BM; nN = N / BM; nwg = nM * nN; G = G_; c = c_; L0 = 0; L1 = nwg; asm volatile("" : "+s"(L1)); }
    __device__ void range(int a, int b) { L0 = a; L1 = b; asm volatile("" : "+s"(L1)); }
    __device__ bool next(int i, Unit& u) const {
        const long L = (long)L0 + (long)i * G + c; if (L >= L1) return false;
        int wgid = (int)L; { const int q = nwg / NXCD, r = nwg % NXCD, xcd = wgid % NXCD, off = wgid / NXCD; wgid = (xcd < r ? xcd * (q + 1) : r * (q + 1) + (xcd - r) * q) + off; }
        const int nig = WGM * nN, gid = wgid / nig, fm = gid * WGM, gsz = (nM - fm) < WGM ? (nM - fm) : WGM;
        u.pm = fm + ((wgid % nig) % gsz); u.pn = (wgid % nig) / gsz; return true;
    }
};
template <class Epi, class Sched, bool ALIGN_EPI>
__device__ __forceinline__ void gemm_phase(LAS unsigned char* lds, const Gemm g, const Sched& S, const Epi& E) {
    int tid_ = threadIdx.x; asm volatile("" : "+v"(tid_));
    const int tid = tid_, wid = __builtin_amdgcn_readfirstlane(tid >> 6), lane = tid & 63, wr = wid >> 2, wc = wid & 3, fr = lane & 15, fq = lane >> 4;
    const int K = g.K, nt = K / BK;
    unsigned voffA[2], voffB[2];
#pragma unroll
    for (int i = 0; i < 2; ++i) { int R, C; stage_rc(tid * 16 + i * 8192, R, C); const int Rb = Epi::PERM ? ((R & ~31) + perm32(R & 31)) : R;
        voffA[i] = (unsigned)(R * K + C) * 2u; voffB[i] = (unsigned)(Rb * K + C) * 2u; }
    const size_t kstep = (size_t)(BK * 2);
    const size_t hstep = (size_t)HALF * K * 2;
    const size_t tstep = 2 * hstep;
    const unsigned ldsw = (unsigned)wid * 1024u;
    const int aoff = lds_byte(wr * 64 + fr, fq * 8), boff = lds_byte(wc * 32 + fr, fq * 8);
#define PG8_SA(b, h) (((b) * 2 + (h)) * HTB)
#define PG8_SB(b, h) ((4 + (b) * 2 + (h)) * HTB)
#define PG8_STAGE(bufoff, gbase, voff) do { _Pragma("unroll") for (int _i = 0; _i < 2; ++_i) \
        __builtin_amdgcn_global_load_lds((const unsigned*)((const char*)(gbase) + (voff)[_i]), (LAS unsigned*)(lds + (bufoff) + ldsw + _i * 8192), 16, 0, 0); } while (0)
#define PG8_LDA(dst, b, h) do { _Pragma("unroll") for (int m = 0; m < 4; ++m) _Pragma("unroll") for (int k = 0; k < 2; ++k) dst[m][k] = *(const LAS bf16x8*)(lds + PG8_SA(b, h) + aoff + m * 2048 + k * 1024); } while (0)
#define PG8_LDB(dst, b, h) do { _Pragma("unroll") for (int n = 0; n < 2; ++n) _Pragma("unroll") for (int k = 0; k < 2; ++k) dst[n][k] = *(const LAS bf16x8*)(lds + PG8_SB(b, h) + boff + n * 2048 + k * 1024); } while (0)
#define PG8_MMA(ai, bj, At, Bt) do { __builtin_amdgcn_s_setprio(1); _Pragma("unroll") for (int m = 0; m < 4; ++m) _Pragma("unroll") for (int n = 0; n < 2; ++n) _Pragma("unroll") for (int k = 0; k < 2; ++k) \
        acc[ai][bj][m][n] = __builtin_amdgcn_mfma_f32_16x16x32_bf16(Bt[n][k], At[m][k], acc[ai][bj][m][n], 0, 0, 0); __builtin_amdgcn_s_setprio(0); } while (0)
#define PG8_WAIT_V(n) asm volatile("s_waitcnt vmcnt(" #n ")" ::: "memory")
#define PG8_WAIT_L(n) asm volatile("s_waitcnt lgkmcnt(" #n ")" ::: "memory")
#define PG8_BAR __builtin_amdgcn_s_barrier()
#define PG8_SCHED __builtin_amdgcn_sched_barrier(0)
#define PG8_APTR(u) ((const char*)((u).pn >= g.asplit ? g.A2 : g.A) + (size_t)(u).pm * tstep)
#define PG8_BPTR(u) ((const char*)g.Bt + (size_t)(u).pn * tstep)
    Unit cur, nxt; int ui = 0;
    if (!S.next(0, cur)) return;
    f32x4 acc[2][2][4][2];
#pragma unroll
    for (int a = 0; a < 2; ++a)
#pragma unroll
        for (int b = 0; b < 2; ++b)
#pragma unroll
            for (int m = 0; m < 4; ++m)
#pragma unroll
                for (int n = 0; n < 2; ++n) acc[a][b][m][n] = (f32x4){0.f, 0.f, 0.f, 0.f};
    bf16x8 At[4][2], B0[2][2], B1[2][2];
    const char* cA = PG8_APTR(cur); const char* cB = PG8_BPTR(cur);
    PG8_STAGE(PG8_SB(0, 0), cB, voffB); PG8_STAGE(PG8_SB(0, 1), cB + hstep, voffB); PG8_STAGE(PG8_SA(0, 0), cA, voffA); PG8_STAGE(PG8_SA(0, 1), cA + hstep, voffA);
    if (wr == 1) PG8_BAR;
    PG8_WAIT_V(2); PG8_BAR;
    PG8_STAGE(PG8_SB(1, 0), cB + kstep, voffB); PG8_STAGE(PG8_SA(1, 0), cA + kstep, voffA); PG8_STAGE(PG8_SB(1, 1), cB + hstep + kstep, voffB);
    PG8_WAIT_V(6); PG8_BAR;
    for (;;) {
        const bool has_next = S.next(ui + 1, nxt);
        const char* nA = has_next ? PG8_APTR(nxt) : cA; const char* nB = has_next ? PG8_BPTR(nxt) : cB;
        for (int t = 0; t < nt; t += 2) {
            const bool last = (t == nt - 2);
            const char* a1 = cA + (size_t)(t + 1) * kstep;
            const char* a2 = last ? nA : cA + (size_t)(t + 2) * kstep; const char* b2 = last ? nB : cB + (size_t)(t + 2) * kstep;
            const char* a3 = a2 + kstep; const char* b3 = b2 + kstep;
            PG8_LDB(B0, 0, 0); PG8_LDB(B1, 0, 1); PG8_SCHED; PG8_LDA(At, 0, 0); PG8_STAGE(PG8_SA(1, 1), a1 + hstep, voffA);
            PG8_WAIT_V(8); PG8_WAIT_L(0); PG8_BAR; PG8_MMA(0, 0, At, B0); PG8_MMA(0, 1, At, B1); PG8_BAR; PG8_SCHED;
            PG8_LDA(At, 0, 1); PG8_STAGE(PG8_SB(0, 0), b2, voffB); PG8_STAGE(PG8_SB(0, 1), b2 + hstep, voffB); PG8_STAGE(PG8_SA(0, 0), a2, voffA);
            PG8_WAIT_V(8); PG8_WAIT_L(0); PG8_BAR; PG8_MMA(1, 0, At, B0); PG8_MMA(1, 1, At, B1); PG8_BAR; PG8_SCHED;
            PG8_LDB(B0, 1, 0); PG8_LDB(B1, 1, 1); PG8_SCHED; PG8_LDA(At, 1, 0); PG8_STAGE(PG8_SA(0, 1), a2 + hstep, voffA);
            PG8_WAIT_V(8); PG8_WAIT_L(0); PG8_BAR; PG8_MMA(0, 0, At, B0); PG8_MMA(0, 1, At, B1); PG8_BAR; PG8_SCHED;
            PG8_LDA(At, 1, 1); PG8_STAGE(PG8_SB(1, 0), b3, voffB); PG8_STAGE(PG8_SB(1, 1), b3 + hstep, voffB); PG8_STAGE(PG8_SA(1, 0), a3, voffA);
            PG8_WAIT_V(8); PG8_WAIT_L(0); PG8_BAR; PG8_MMA(1, 0, At, B0); PG8_MMA(1, 1, At, B1); PG8_BAR; PG8_SCHED;
        }
        if constexpr (ALIGN_EPI) { if (wr == 0) PG8_BAR; }
        E(acc, cur, wr, wc, fr, fq);
        if (!has_next) break;
#pragma unroll
        for (int a = 0; a < 2; ++a)
#pragma unroll
            for (int b = 0; b < 2; ++b)
#pragma unroll
                for (int m = 0; m < 4; ++m)
#pragma unroll
                    for (int n = 0; n < 2; ++n) acc[a][b][m][n] = (f32x4){0.f, 0.f, 0.f, 0.f};
        cur = nxt; cA = nA; cB = nB; ++ui;
        if constexpr (ALIGN_EPI) { if (wr == 1) PG8_BAR; }
    }
    PG8_WAIT_V(0);
    if constexpr (!ALIGN_EPI) { if (wr == 0) PG8_BAR; }
    PG8_BAR;
#undef PG8_SA
#undef PG8_SB
#undef PG8_STAGE
#undef PG8_LDA
#undef PG8_LDB
#undef PG8_MMA
#undef PG8_WAIT_V
#undef PG8_WAIT_L
#undef PG8_BAR
#undef PG8_SCHED
#undef PG8_APTR
#undef PG8_BPTR
}
}

struct Params {
    const float* x; const float* meta; const float* norm_w; const float* w_in; const float* sinks; const float* mu; const float* w0; const float* w2;
    const float* a0; const float* a2; const float* k_k; const float* k_a; const float* r_k; const float* ln_w; const float* ln_b;
    const float* w_ba; const float* w_br; const float* w_out; const float* fnw;
    float* out; unsigned char* ws;
};

struct EpiP1 {
    static constexpr bool PERM = true;
    bf16_t *Q, *KV, *RKV, *WA; const float* rope;
    __device__ __forceinline__ void operator()(const f32x4 (&acc)[2][2][4][2], const pg8::Unit& u, int wr, int wc, int fr, int fq) const {
        asm volatile("" : "+v"(fr), "+v"(fq));
        const int pn = u.pn, row0 = u.pm * 256 + wr * 64 + fr, cl = wc * 32 + 8 * fq;
        if (pn <= 4) {
            const float sc = pn < 4 ? QSCALE : 1.f;
#pragma unroll
            for (int ai = 0; ai < 2; ++ai)
#pragma unroll
                for (int m = 0; m < 4; ++m) {
                    const int row = row0 + ai * 128 + m * 16;
                    const int pos = row < MREAL ? (row & (SEQ - 1)) + NMETA : row - MREAL;
                    const float* rp = rope + (size_t)pos * 64;
#pragma unroll
                    for (int bj = 0; bj < 2; ++bj) {
                        const int col = bj * 128 + cl;
                        f32x4 v0 = acc[ai][bj][m][0], v1 = acc[ai][bj][m][1];
                        u32x4 w;
                        if (pn == 4 && bj == 1) {
                            w.x = cvt_pk_bf16(v0[0], v0[1]); w.y = cvt_pk_bf16(v0[2], v0[3]); w.z = cvt_pk_bf16(v1[0], v1[1]); w.w = cvt_pk_bf16(v1[2], v1[3]);
                        } else {
                            const int i0 = (col & 63) >> 1;
                            const f32x4 c = *(const f32x4*)(rp + i0), s = *(const f32x4*)(rp + 32 + i0);
                            w.x = cvt_pk_bf16((v0[0] * c[0] - v0[1] * s[0]) * sc, (v0[1] * c[0] + v0[0] * s[0]) * sc);
                            w.y = cvt_pk_bf16((v0[2] * c[1] - v0[3] * s[1]) * sc, (v0[3] * c[1] + v0[2] * s[1]) * sc);
                            w.z = cvt_pk_bf16((v1[0] * c[2] - v1[1] * s[2]) * sc, (v1[1] * c[2] + v1[0] * s[2]) * sc);
                            w.w = cvt_pk_bf16((v1[2] * c[3] - v1[3] * s[3]) * sc, (v1[3] * c[3] + v1[2] * s[3]) * sc);
                        }
                        bf16_t* dst = pn < 4 ? Q + (size_t)row * 1024 + pn * 256 + col : KV + (size_t)row * 256 + col;
                        *(u32x4*)dst = w;
                    }
                }
        } else {
#pragma unroll
            for (int ai = 0; ai < 2; ++ai)
#pragma unroll
                for (int m = 0; m < 4; ++m) {
                    const int row = row0 + ai * 128 + m * 16;
#pragma unroll
                    for (int bj = 0; bj < 2; ++bj) {
                        const int col = bj * 128 + cl;
                        const f32x4 v0 = acc[ai][bj][m][0], v1 = acc[ai][bj][m][1];
                        u32x4 w; w.x = cvt_pk_bf16(v0[0], v0[1]); w.y = cvt_pk_bf16(v0[2], v0[3]); w.z = cvt_pk_bf16(v1[0], v1[1]); w.w = cvt_pk_bf16(v1[2], v1[3]);
                        if (pn < 17) *(u32x4*)(RKV + (size_t)row * 3072 + (pn - 5) * 256 + col) = w;
                        else if (bj == 0) *(u32x4*)(WA + (size_t)row * 128 + col) = w;
                    }
                }
        }
    }
};
struct EpiGate {
    static constexpr bool PERM = true;
    bf16_t *Q, *RW, *SG; int pn_off;
    __device__ __forceinline__ void operator()(const f32x4 (&acc)[2][2][4][2], const pg8::Unit& u, int wr, int wc, int fr, int fq) const {
        asm volatile("" : "+v"(fr), "+v"(fq));
        const int pn = u.pn + pn_off, row0 = u.pm * 256 + wr * 64 + fr, cl = wc * 32 + 8 * fq;
#pragma unroll
        for (int ai = 0; ai < 2; ++ai)
#pragma unroll
            for (int m = 0; m < 4; ++m) {
                const int row = row0 + ai * 128 + m * 16;
#pragma unroll
                for (int bj = 0; bj < 2; ++bj) {
                    const int col = bj * 128 + cl;
                    const f32x4 v0 = acc[ai][bj][m][0], v1 = acc[ai][bj][m][1];
                    u32x4 w;
                    if (pn < 8) {
                        bf16_t* p = (pn < 4 ? Q + (size_t)row * 1024 + pn * 256 : RW + (size_t)row * 1024 + (pn - 4) * 256) + col;
                        const u32x4 a = *(const u32x4*)p;
                        w.x = cvt_pk_bf16(bflo(a.x) * siluf_(v0[0]), bfhi(a.x) * siluf_(v0[1]));
                        w.y = cvt_pk_bf16(bflo(a.y) * siluf_(v0[2]), bfhi(a.y) * siluf_(v0[3]));
                        w.z = cvt_pk_bf16(bflo(a.z) * siluf_(v1[0]), bfhi(a.z) * siluf_(v1[1]));
                        w.w = cvt_pk_bf16(bflo(a.w) * siluf_(v1[2]), bfhi(a.w) * siluf_(v1[3]));
                        *(u32x4*)p = w;
                    } else {
                        w.x = cvt_pk_bf16(sigmoidf_(v0[0]), sigmoidf_(v0[1])); w.y = cvt_pk_bf16(sigmoidf_(v0[2]), sigmoidf_(v0[3]));
                        w.z = cvt_pk_bf16(sigmoidf_(v1[0]), sigmoidf_(v1[1])); w.w = cvt_pk_bf16(sigmoidf_(v1[2]), sigmoidf_(v1[3]));
                        *(u32x4*)(SG + (size_t)row * 2048 + (pn - 8) * 256 + col) = w;
                    }
                }
                asm volatile("" ::: "memory");
            }
    }
};
struct EpiBranch {
    static constexpr bool PERM = true;
    bf16_t* MG; const bf16_t* SG; int pn_off;
    __device__ __forceinline__ void operator()(const f32x4 (&acc)[2][2][4][2], const pg8::Unit& u, int wr, int wc, int fr, int fq) const {
        asm volatile("" : "+v"(fr), "+v"(fq));
        const int pn = u.pn + pn_off, pc = pn & 3, row0 = u.pm * 256 + wr * 64 + fr, cl = wc * 32 + 8 * fq;
        const unsigned so0 = (unsigned)row0 * 2048u + (unsigned)((pn >= 4 ? 1024 : 0) + pc * 256 + cl), mo0 = (unsigned)row0 * 1024u + (unsigned)(pc * 256 + cl);
#pragma unroll
        for (int ai = 0; ai < 2; ++ai)
#pragma unroll
            for (int mh = 0; mh < 2; ++mh) {
                u32x4 sg[2][2], pa[2][2];
#pragma unroll
                for (int mm = 0; mm < 2; ++mm)
#pragma unroll
                    for (int bj = 0; bj < 2; ++bj) { const int m = 2 * mh + mm;
                        sg[mm][bj] = *(const u32x4*)(SG + (so0 + (unsigned)((ai * 128 + m * 16) * 2048 + bj * 128)));
                        if (pn >= 4) pa[mm][bj] = *(const u32x4*)(MG + (mo0 + (unsigned)((ai * 128 + m * 16) * 1024 + bj * 128))); else pa[mm][bj] = (u32x4){0u, 0u, 0u, 0u}; }
#pragma unroll
                for (int mm = 0; mm < 2; ++mm)
#pragma unroll
                    for (int bj = 0; bj < 2; ++bj) { const int m = 2 * mh + mm;
                        const f32x4 v0 = acc[ai][bj][m][0], v1 = acc[ai][bj][m][1]; const u32x4 sv = sg[mm][bj], a = pa[mm][bj];
                        u32x4 w;
                        w.x = cvt_pk_bf16(bflo(sv.x) * v0[0] + bflo(a.x), bfhi(sv.x) * v0[1] + bfhi(a.x));
                        w.y = cvt_pk_bf16(bflo(sv.y) * v0[2] + bflo(a.y), bfhi(sv.y) * v0[3] + bfhi(a.y));
                        w.z = cvt_pk_bf16(bflo(sv.z) * v1[0] + bflo(a.z), bfhi(sv.z) * v1[1] + bfhi(a.z));
                        w.w = cvt_pk_bf16(bflo(sv.w) * v1[2] + bflo(a.w), bfhi(sv.w) * v1[3] + bfhi(a.w));
                        *(u32x4*)(MG + (mo0 + (unsigned)((ai * 128 + m * 16) * 1024 + bj * 128))) = w;
                    }
                asm volatile("" ::: "memory");
            }
    }
};
struct EpiOut {
    static constexpr bool PERM = false;
    const float* x; float* out; float* rowss;
    __device__ __forceinline__ void operator()(const f32x4 (&acc)[2][2][4][2], const pg8::Unit& u, int wr, int wc, int fr, int fq) const {
        asm volatile("" : "+v"(fr), "+v"(fq));
        const int row0 = u.pm * 256 + wr * 64 + fr, col0 = u.pn * 256 + wc * 32 + 4 * fq;
        const unsigned xo0 = (unsigned)row0 * 1024u + (unsigned)col0;
#pragma unroll
        for (int ai = 0; ai < 2; ++ai)
#pragma unroll
            for (int mh = 0; mh < 2; ++mh) {
                f32x4 xl[2][2][2];
#pragma unroll
                for (int mm = 0; mm < 2; ++mm)
#pragma unroll
                    for (int bj = 0; bj < 2; ++bj)
#pragma unroll
                        for (int n = 0; n < 2; ++n) xl[mm][bj][n] = *(const f32x4*)(x + (xo0 + (unsigned)((ai * 128 + (2 * mh + mm) * 16) * 1024 + bj * 128 + n * 16)));
#pragma unroll
                for (int mm = 0; mm < 2; ++mm) { const int m = 2 * mh + mm;
                    float ss = 0.f;
#pragma unroll
                    for (int bj = 0; bj < 2; ++bj)
#pragma unroll
                        for (int n = 0; n < 2; ++n) {
                            const f32x4 h = xl[mm][bj][n] + acc[ai][bj][m][n];
                            ss += (h[0] * h[0] + h[1] * h[1]) + (h[2] * h[2] + h[3] * h[3]);
                            *(f32x4*)(out + (xo0 + (unsigned)((ai * 128 + m * 16) * 1024 + bj * 128 + n * 16))) = h;
                        }
                    ss += __shfl_xor(ss, 16); ss += __shfl_xor(ss, 32);
                    if (fq == 0) atomicAdd(rowss + row0 + ai * 128 + m * 16, ss);
                }
                asm volatile("" ::: "memory");
            }
    }
};

__device__ __forceinline__ int win_dest(int n) {
    if (n < 1152) { const int hh = n >> 6, d = n & 63; return (hh << 6) + 2 * (d & 31) + (d >> 5); }
    if (n < 1280) return n;
    if (n < 2304) return 4608 + (n - 1280);
    if (n < 5504) return 1280 + (n - 2304);
    if (n < 6528) return 5632 + (n - 5504);
    return 6656 + (n - 6528);
}
template <bool MAPPED>
__device__ __forceinline__ void p0_transpose_item(const float* W, int N, bf16_t* WT, LAS float* scr, int item, int lane) {
    const int nblk = N / 32, kb = item / nblk, nb = item % nblk, k0 = 64 * kb, n0 = 32 * nb;
#pragma unroll 8
    for (int i = 0; i < 32; ++i) { const int kk = 2 * i + (lane >> 5); scr[kk * 33 + (lane & 31)] = W[(size_t)(k0 + kk) * N + n0 + (lane & 31)]; }
    asm volatile("s_waitcnt lgkmcnt(0)" ::: "memory");
    const int c = lane & 7;
#pragma unroll
    for (int j = 0; j < 4; ++j) { const int n = (lane >> 3) + 8 * j; const LAS float* s = scr + (8 * c) * 33 + n;
        u32x4 o; o.x = cvt_pk_bf16(s[0 * 33], s[1 * 33]); o.y = cvt_pk_bf16(s[2 * 33], s[3 * 33]); o.z = cvt_pk_bf16(s[4 * 33], s[5 * 33]); o.w = cvt_pk_bf16(s[6 * 33], s[7 * 33]);
        const int dr = MAPPED ? win_dest(n0 + n) : n0 + n;
        *(u32x4*)(WT + (size_t)dr * 1024 + k0 + 8 * c) = o; }
    asm volatile("s_waitcnt lgkmcnt(0)" ::: "memory");
}
__device__ __forceinline__ void rms_row_to_bf16(const float* xrow, const float* nw, bf16_t* orow, int lane) {
    const f32x4* xr = (const f32x4*)xrow + lane; const f32x4* wr4 = (const f32x4*)nw + lane;
    f32x4 v[4]; float s = 0.f;
#pragma unroll
    for (int j = 0; j < 4; ++j) { v[j] = xr[64 * j]; s += (v[j][0] * v[j][0] + v[j][1] * v[j][1]) + (v[j][2] * v[j][2] + v[j][3] * v[j][3]); }
    const float rstd = 1.f / sqrtf(wave_sum(s) * (1.f / DM) + RMS_EPS);
    u32x2* o8 = (u32x2*)orow + lane;
#pragma unroll
    for (int j = 0; j < 4; ++j) { const f32x4 w = wr4[64 * j]; u32x2 o; o.x = cvt_pk_bf16(v[j][0] * rstd * w[0], v[j][1] * rstd * w[1]); o.y = cvt_pk_bf16(v[j][2] * rstd * w[2], v[j][3] * rstd * w[3]); o8[64 * j] = o; }
}
__device__ __forceinline__ void p0_prologue(const Params& P, LAS unsigned char* lds, int G) {
    const int tid = threadIdx.x, lane = tid & 63, wave = tid >> 6;
    LAS float* scr = (LAS float*)(lds + wave * 16384);
    const int gw = blockIdx.x * 8 + wave, NGW = G * 8;
    bf16_t* WinT = (bf16_t*)(P.ws + WS_WIN); bf16_t* WbT = (bf16_t*)(P.ws + WS_WB); bf16_t* WoT = (bf16_t*)(P.ws + WS_WOUT);
    constexpr int I_IN = 16 * (NIN_SRC / 32), I_SQ = 16 * 32;
    for (int it = gw; it < I_IN + 3 * I_SQ; it += NGW) {
        int r = it;
        if (r < I_IN) { p0_transpose_item<true>(P.w_in, NIN_SRC, WinT, scr, r, lane); continue; } r -= I_IN;
        if (r < I_SQ) { p0_transpose_item<false>(P.w_ba, 1024, WbT, scr, r, lane); continue; } r -= I_SQ;
        if (r < I_SQ) { p0_transpose_item<false>(P.w_br, 1024, WbT + (size_t)1024 * 1024, scr, r, lane); continue; } r -= I_SQ;
        p0_transpose_item<false>(P.w_out, 1024, WoT, scr, r, lane);
    }
    for (int i = blockIdx.x * 512 + tid; i < 16384; i += G * 512) *((u32x4*)(WinT + (size_t)4480 * 1024) + i) = (u32x4){0u, 0u, 0u, 0u};
    bf16_t* U = (bf16_t*)(P.ws + WS_U);
    for (int m = gw; m < MREAL + NMETA; m += NGW) {
        const float* src = m < MREAL ? P.x + (size_t)m * DM : P.meta + (size_t)(m - MREAL) * DM;
        rms_row_to_bf16(src, P.norm_w, U + (size_t)m * DM, lane);
    }
    float* rope = (float*)(P.ws + WS_ROPE);
    for (int i = blockIdx.x * 512 + tid; i < TT * 32; i += G * 512) {
        const int pos = i >> 5, k = i & 31;
        const double inv = exp(-9.210340371976184 * (double)k / 32.0);
        const double ang = (double)pos * inv;
        rope[pos * 64 + k] = (float)cos(ang); rope[pos * 64 + 32 + k] = (float)sin(ang);
    }
}

constexpr int KS_STRIDE = 144;
constexpr int VT_STRIDE = 520;
constexpr int ATT_KS = 0, ATT_VT = 256 * KS_STRIDE;
__device__ __forceinline__ int crow(int r, int hi) { return (r & 3) + 8 * (r >> 2) + 4 * hi; }
__device__ __forceinline__ void attn_unit(const Params& P, LAS unsigned char* lds, int unit) {
    int tid_ = threadIdx.x; asm volatile("" : "+v"(tid_));
    const int tid = tid_, lane = tid & 63, wid = tid >> 6, qc = lane & 31, hi = lane >> 5;
    const int g = unit & 1, qb = (unit >> 1) & 63, b = unit >> 7;
    bf16_t* Q = (bf16_t*)(P.ws + WS_Q); const bf16_t* KV = (const bf16_t*)(P.ws + WS_KV);
    const int rb = b * SEQ + qb * 128;
    __syncthreads();
#pragma unroll
    for (int i = 0; i < 4; ++i) {
        const int id = tid + 512 * i, c = id >> 3, ch = id & 7;
        int row; bool ok = true;
        if (c >= 128) row = rb + c - 128; else if (qb > 0) row = rb - 128 + c; else { ok = c >= 112; row = MREAL + c - 112; }
        u32x4 kq = (u32x4){0u, 0u, 0u, 0u}, vq = kq;
        if (ok) { kq = *(const u32x4*)(KV + (size_t)row * 256 + g * 64 + ch * 8); vq = *(const u32x4*)(KV + (size_t)row * 256 + 128 + g * 64 + ch * 8); }
        *(LAS u32x4*)(lds + ATT_KS + c * KS_STRIDE + ch * 16) = kq;
        LAS unsigned short* vt = (LAS unsigned short*)(lds + ATT_VT) + (ch * 8) * (VT_STRIDE / 2) + c;
        vt[0 * (VT_STRIDE / 2)] = (unsigned short)(vq.x & 0xffff); vt[1 * (VT_STRIDE / 2)] = (unsigned short)(vq.x >> 16);
        vt[2 * (VT_STRIDE / 2)] = (unsigned short)(vq.y & 0xffff); vt[3 * (VT_STRIDE / 2)] = (unsigned short)(vq.y >> 16);
        vt[4 * (VT_STRIDE / 2)] = (unsigned short)(vq.z & 0xffff); vt[5 * (VT_STRIDE / 2)] = (unsigned short)(vq.z >> 16);
        vt[6 * (VT_STRIDE / 2)] = (unsigned short)(vq.w & 0xffff); vt[7 * (VT_STRIDE / 2)] = (unsigned short)(vq.w >> 16);
    }
    __syncthreads();
    const int h = g * 8 + wid;
    const float sink2 = P.sinks[h] * LOG2E;
    for (int qt = 0; qt < 4; ++qt) {
        bf16_t* qrow = Q + (size_t)(rb + qt * 32 + qc) * 1024 + h * 64;
        bf16x8 qf[4];
#pragma unroll
        for (int s = 0; s < 4; ++s) qf[s] = *(const bf16x8*)(qrow + s * 16 + hi * 8);
        f32x16 sc[5];
#pragma unroll
        for (int jj = 0; jj < 5; ++jj) {
            sc[jj] = (f32x16){0.f};
            const LAS unsigned char* kp = lds + ATT_KS + (32 * (qt + jj) + qc) * KS_STRIDE + hi * 16;
#pragma unroll
            for (int s = 0; s < 4; ++s) { const bf16x8 kf = *(const LAS bf16x8*)(kp + s * 32); sc[jj] = __builtin_amdgcn_mfma_f32_32x32x16_bf16(kf, qf[s], sc[jj], 0, 0, 0); }
        }
        float mx = sink2;
#pragma unroll
        for (int jj = 0; jj < 5; ++jj)
#pragma unroll
            for (int r = 0; r < 16; ++r) {
                const int kr = crow(r, hi);
                bool ok = true;
                if (jj == 0) ok = kr >= qc + 1;
                if (jj == 4) ok = kr <= qc;
                if (qb == 0) ok = ok && (32 * (qt + jj) + kr >= 112);
                const float v = ok ? sc[jj][r] : -1e30f;
                sc[jj][r] = v; mx = fmaxf(mx, v);
            }
        { auto rr = __builtin_amdgcn_permlane32_swap(__float_as_uint(mx), __float_as_uint(mx), false, false); mx = fmaxf(__uint_as_float(rr[0]), __uint_as_float(rr[1])); }
        float l = 0.f;
#pragma unroll
        for (int jj = 0; jj < 5; ++jj)
#pragma unroll
            for (int r = 0; r < 16; ++r) { const float p = __builtin_amdgcn_exp2f(sc[jj][r] - mx); sc[jj][r] = p; l += p; }
        { auto rr = __builtin_amdgcn_permlane32_swap(__float_as_uint(l), __float_as_uint(l), false, false); l = __uint_as_float(rr[0]) + __uint_as_float(rr[1]); }
        l += __builtin_amdgcn_exp2f(sink2 - mx);
        const float rl = 1.f / l;
        f32x16 o[2]; o[0] = (f32x16){0.f}; o[1] = (f32x16){0.f};
#pragma unroll
        for (int jj = 0; jj < 5; ++jj)
#pragma unroll
            for (int t = 0; t < 2; ++t) {
                u32x4 pw; pw.x = cvt_pk_bf16(sc[jj][8 * t + 0], sc[jj][8 * t + 1]); pw.y = cvt_pk_bf16(sc[jj][8 * t + 2], sc[jj][8 * t + 3]);
                pw.z = cvt_pk_bf16(sc[jj][8 * t + 4], sc[jj][8 * t + 5]); pw.w = cvt_pk_bf16(sc[jj][8 * t + 6], sc[jj][8 * t + 7]);
                const bf16x8 pf = __builtin_bit_cast(bf16x8, pw);
#pragma unroll
                for (int dt = 0; dt < 2; ++dt) {
                    const LAS unsigned char* vp = lds + ATT_VT + (32 * dt + qc) * VT_STRIDE + (32 * (qt + jj) + 16 * t + 4 * hi) * 2;
                    const u32x2 lo = *(const LAS u32x2*)vp, hi2 = *(const LAS u32x2*)(vp + 16);
                    const u32x4 vw = (u32x4){lo.x, lo.y, hi2.x, hi2.y};
                    o[dt] = __builtin_amdgcn_mfma_f32_32x32x16_bf16(__builtin_bit_cast(bf16x8, vw), pf, o[dt], 0, 0, 0);
                }
            }
#pragma unroll
        for (int dt = 0; dt < 2; ++dt)
#pragma unroll
            for (int rq = 0; rq < 4; ++rq) {
                u32x2 w; w.x = cvt_pk_bf16(o[dt][4 * rq + 0] * rl, o[dt][4 * rq + 1] * rl); w.y = cvt_pk_bf16(o[dt][4 * rq + 2] * rl, o[dt][4 * rq + 3] * rl);
                *(u32x2*)(qrow + 32 * dt + 8 * rq + 4 * hi) = w;
            }
    }
}

constexpr int TC = 32;
constexpr int SC_W2 = 0, SC_A2 = 16384, SC_TW = 32768, SC_ZAL = 40960, SC_R = 49152, SC_W = 57344, SC_K = 65536, SC_A = 73728, SC_B = 81920, SC_V = 90112, SC_Y = 98304, SC_BON = 106496;
__device__ __forceinline__ void scan_item(const Params& P, LAS unsigned char* lds, int item) {
    const int tid = threadIdx.x, lane = tid & 63, wid = tid >> 6;
    const int b = item >> 4, h = item & 15, hj = h * 64 + lane;
    const bf16_t* RKV = (const bf16_t*)(P.ws + WS_RKV); const bf16_t* WA = (const bf16_t*)(P.ws + WS_WA); bf16_t* RW = (bf16_t*)(P.ws + WS_RW);
    LAS float* w2s = (LAS float*)(lds + SC_W2); LAS float* a2s = (LAS float*)(lds + SC_A2); LAS float* tw = (LAS float*)(lds + SC_TW); LAS float* zal = (LAS float*)(lds + SC_ZAL);
    LAS float* Rs = (LAS float*)(lds + SC_R); LAS float* Ws = (LAS float*)(lds + SC_W); LAS float* Ks = (LAS float*)(lds + SC_K); LAS float* As = (LAS float*)(lds + SC_A);
    LAS float* Bs = (LAS float*)(lds + SC_B); LAS float* Vs = (LAS float*)(lds + SC_V); LAS float* Ys = (LAS float*)(lds + SC_Y); LAS float* BON = (LAS float*)(lds + SC_BON);
    __syncthreads();
    for (int i = tid; i < 4096; i += 512) { const int r = i >> 6, c = i & 63; w2s[i] = P.w2[(size_t)r * 1024 + h * 64 + c]; a2s[i] = P.a2[(size_t)r * 1024 + h * 64 + c]; }
    const float mu_r = P.mu[hj], mu_k = P.mu[1024 + hj], mu_v = P.mu[2048 + hj], mu_wl = P.mu[3072 + lane], mu_al = P.mu[3136 + lane];
    const float w0v = P.w0[hj], a0v = P.a0[hj], kkv = P.k_k[hj], kav = P.k_a[hj], rkv = P.r_k[hj], lnw = P.ln_w[hj], lnb = P.ln_b[hj];
    float S[8];
#pragma unroll
    for (int c = 0; c < 8; ++c) S[c] = 0.f;
    const int srow = tid >> 3, scg = tid & 7;
    for (int t0 = 0; t0 < TT; t0 += TC) {
        const int nt = (TT - t0) < TC ? (TT - t0) : TC;
        float zr[4], zk[4], zv[4];
        {
            float pr = 0.f, pk = 0.f, pv = 0.f, pwl = 0.f, pal = 0.f;
            const int tp = t0 + 4 * wid - 1;
            if (tp >= 0 && tp < TT) { const size_t row = tp < NMETA ? (size_t)MREAL + tp : (size_t)b * SEQ + tp - NMETA;
                pr = bf2f(RKV[row * 3072 + hj]); pk = bf2f(RKV[row * 3072 + 1024 + hj]); pv = bf2f(RKV[row * 3072 + 2048 + hj]); pwl = bf2f(WA[row * 128 + lane]); pal = bf2f(WA[row * 128 + 64 + lane]); }
#pragma unroll
            for (int q = 0; q < 4; ++q) {
                const int tl = 4 * wid + q, tk = t0 + tl;
                float cr = 0.f, ck = 0.f, cv = 0.f, cwl = 0.f, cal = 0.f;
                if (tk < TT) { const size_t row = tk < NMETA ? (size_t)MREAL + tk : (size_t)b * SEQ + tk - NMETA;
                    cr = bf2f(RKV[row * 3072 + hj]); ck = bf2f(RKV[row * 3072 + 1024 + hj]); cv = bf2f(RKV[row * 3072 + 2048 + hj]); cwl = bf2f(WA[row * 128 + lane]); cal = bf2f(WA[row * 128 + 64 + lane]); }
                zr[q] = cr + (pr - cr) * mu_r; zk[q] = ck + (pk - ck) * mu_k; zv[q] = cv + (pv - cv) * mu_v;
                tw[tl * 64 + lane] = tanhf(cwl + (pwl - cwl) * mu_wl); zal[tl * 64 + lane] = cal + (pal - cal) * mu_al;
                pr = cr; pk = ck; pv = cv; pwl = cwl; pal = cal;
            }
        }
        __syncthreads();
        float aw[4], aa[4];
#pragma unroll
        for (int q = 0; q < 4; ++q) { aw[q] = w0v; aa[q] = a0v; }
        for (int i = 0; i < 64; ++i) {
            const float wv = w2s[i * 64 + lane], av = a2s[i * 64 + lane];
#pragma unroll
            for (int q = 0; q < 4; ++q) { aw[q] += tw[(4 * wid + q) * 64 + i] * wv; aa[q] += zal[(4 * wid + q) * 64 + i] * av; }
        }
#pragma unroll
        for (int q = 0; q < 4; ++q) {
            const int tl = 4 * wid + q;
            const float y = -aw[q];
            const float sp = fmaxf(y, 0.f) + log1pf(expf(-fabsf(y)));
            const float wlog = -sp - 0.5f;
            const float decay = expf(-expf(wlog));
            const float a = 1.f / (1.f + expf(-aa[q]));
            float kk = zk[q] * kkv;
            const float n2 = wave_sum(kk * kk);
            kk = kk / fmaxf(sqrtf(n2), 1e-12f);
            const float kp = zk[q] * (1.f + (a - 1.f) * kav);
            const float bon = wave_sum(zr[q] * kp * rkv);
            Rs[tl * 64 + lane] = zr[q]; Ws[tl * 64 + lane] = decay; Ks[tl * 64 + lane] = kp; As[tl * 64 + lane] = -kk; Bs[tl * 64 + lane] = kk * a; Vs[tl * 64 + lane] = zv[q];
            if (lane == 0) BON[tl] = bon;
        }
        __syncthreads();
        for (int t = 0; t < nt; ++t) {
            const f32x4 w_0 = *(const LAS f32x4*)(Ws + t * 64 + 8 * scg), w_1 = *(const LAS f32x4*)(Ws + t * 64 + 8 * scg + 4);
            const f32x4 a_0 = *(const LAS f32x4*)(As + t * 64 + 8 * scg), a_1 = *(const LAS f32x4*)(As + t * 64 + 8 * scg + 4);
            const f32x4 b_0 = *(const LAS f32x4*)(Bs + t * 64 + 8 * scg), b_1 = *(const LAS f32x4*)(Bs + t * 64 + 8 * scg + 4);
            const f32x4 k_0 = *(const LAS f32x4*)(Ks + t * 64 + 8 * scg), k_1 = *(const LAS f32x4*)(Ks + t * 64 + 8 * scg + 4);
            const f32x4 r_0 = *(const LAS f32x4*)(Rs + t * 64 + 8 * scg), r_1 = *(const LAS f32x4*)(Rs + t * 64 + 8 * scg + 4);
            const float v = Vs[t * 64 + srow];
            float sa = (S[0] * a_0[0] + S[1] * a_0[1]) + (S[2] * a_0[2] + S[3] * a_0[3]) + (S[4] * a_1[0] + S[5] * a_1[1]) + (S[6] * a_1[2] + S[7] * a_1[3]);
            sa = red8(sa);
#pragma unroll
            for (int c = 0; c < 4; ++c) { S[c] = S[c] * w_0[c] + sa * b_0[c] + v * k_0[c]; S[4 + c] = S[4 + c] * w_1[c] + sa * b_1[c] + v * k_1[c]; }
            float y = (S[0] * r_0[0] + S[1] * r_0[1]) + (S[2] * r_0[2] + S[3] * r_0[3]) + (S[4] * r_1[0] + S[5] * r_1[1]) + (S[6] * r_1[2] + S[7] * r_1[3]);
            y = red8(y);
            if (scg == 0) Ys[t * 64 + srow] = y;
        }
        __syncthreads();
#pragma unroll
        for (int q = 0; q < 4; ++q) {
            const int tl = 4 * wid + q, tk = t0 + tl;
            const float y = Ys[tl * 64 + lane];
            const float mean = wave_sum(y) * (1.f / 64.f);
            const float d = y - mean;
            const float var = wave_sum(d * d) * (1.f / 64.f);
            const float o = d * (1.f / sqrtf(var + GN_EPS)) * lnw + lnb + BON[tl] * Vs[tl * 64 + lane];
            if (tl < nt && tk >= NMETA) RW[((size_t)b * SEQ + tk - NMETA) * 1024 + hj] = f2bf(o);
        }
        __syncthreads();
    }
}

constexpr int CH = 16, NCHUNK = TT / CH;
constexpr int IMG_STRIDE = 144;
constexpr int SL_IMG_A = 0, SL_IMG_R = 2304, SL_IMG_B = 4608, SL_IMG_K = 6912, SL_IMG_V = 9216, SL_NAK = 11520, SL_TT = 12032, SL_MT = 12544, SL_GAM = 13568, SL_BON = 13824, SLOT_BYTES = 13888;
constexpr int SCR_STRIDE = 272;
constexpr int SL_SCR_W = 0, SL_SCR_A = 16 * SCR_STRIDE;
constexpr int NSLOT = 8;
constexpr int CS_W2IMG = NSLOT * SLOT_BYTES, CS_A2IMG = CS_W2IMG + 8192, CS_CONST = CS_A2IMG + 8192, CS_FLAGS = CS_CONST + 12 * 256, CS_YRING = CS_FLAGS + 64, YENT_BYTES = 16 * IMG_STRIDE, CS_END = CS_YRING + 8 * YENT_BYTES;
static_assert(CS_END + 16 <= LDS_BYTES, "scan LDS map");
enum { CK_MU_R = 0, CK_MU_K, CK_MU_V, CK_MU_WL, CK_MU_AL, CK_W0, CK_A0, CK_KK, CK_KA, CK_RK, CK_LNW, CK_LNB };
typedef short v4i16 __attribute__((ext_vector_type(4)));
__device__ __forceinline__ u32x2 lds_tr16(const LAS unsigned char* p) { return __builtin_bit_cast(u32x2, __builtin_amdgcn_ds_read_tr16_b64_v4i16((LAS v4i16*)p)); }
__device__ __forceinline__ void lds_wait_ge(LAS unsigned char* p, int v) { while (*(volatile LAS int*)p < v) __builtin_amdgcn_s_sleep(1); asm volatile("" ::: "memory"); }
__device__ __forceinline__ void lds_flag_set(LAS unsigned char* p, int v, int lane) { asm volatile("s_waitcnt lgkmcnt(0)" ::: "memory"); if (lane == 0) *(volatile LAS int*)p = v; asm volatile("" ::: "memory"); }
__device__ __forceinline__ bf16x8 mk_frag(u32x2 lo, u32x2 hi) { return __builtin_bit_cast(bf16x8, (u32x4){lo.x, lo.y, hi.x, hi.y}); }
__device__ __forceinline__ u32x2 pk4(f32x4 v) { return (u32x2){cvt_pk_bf16(v[0], v[1]), cvt_pk_bf16(v[2], v[3])}; }
__device__ __forceinline__ void unpack8(u32x4 w, float* f) { f[0] = bflo(w.x); f[1] = bfhi(w.x); f[2] = bflo(w.y); f[3] = bfhi(w.y); f[4] = bflo(w.z); f[5] = bfhi(w.z); f[6] = bflo(w.w); f[7] = bfhi(w.w); }
__device__ __forceinline__ u32x4 pack8(const float* f) { return (u32x4){cvt_pk_bf16(f[0], f[1]), cvt_pk_bf16(f[2], f[3]), cvt_pk_bf16(f[4], f[5]), cvt_pk_bf16(f[6], f[7])}; }
__device__ __forceinline__ float red16(float v) {
    v += dppf<0xB1>(v); v += dppf<0x4E>(v); v += dppf<0x141>(v); v += dppf<0x140>(v); return v;
}
__device__ __forceinline__ float scan16(float v) {
    v += dppf<0x111>(v); v += dppf<0x112>(v); v += dppf<0x114>(v); v += dppf<0x118>(v); return v;
}
__device__ __forceinline__ float shr1_fill1(float v) {
    return __builtin_bit_cast(float, __builtin_amdgcn_update_dpp(0x3f800000, __builtin_bit_cast(int, v), 0x111, 0xF, 0xF, false));
}
#define MFMA32(a, b, c) __builtin_amdgcn_mfma_f32_16x16x32_bf16((a), (b), (c), 0, 0, 0)

__device__ __forceinline__ size_t scan_row(int b, int tau) { return tau < NMETA ? (size_t)MREAL + tau : (size_t)b * SEQ + (tau - NMETA); }

__device__ __forceinline__ unsigned long long scan_producer(const Params& P, LAS unsigned char* lds, int b, int h, int pidx, int lane) {
    unsigned long long pticks = 0ull;
    const int t = lane & 15, g = lane >> 4;
    const bf16_t* RKV = (const bf16_t*)(P.ws + WS_RKV); const bf16_t* WA = (const bf16_t*)(P.ws + WS_WA);
    const LAS unsigned char* cst = lds + CS_CONST;
    const f32x4 fzero = (f32x4){0.f, 0.f, 0.f, 0.f};
    u32x4 raw_wa[2][2][2];
#define ISSUE_WA(cc) do { const int tau_ = 16 * (cc) + t; const size_t rc_ = scan_row(b, tau_), rp_ = scan_row(b, tau_ > 0 ? tau_ - 1 : 0); \
        _Pragma("unroll") for (int s_ = 0; s_ < 2; ++s_) _Pragma("unroll") for (int a_ = 0; a_ < 2; ++a_) { \
            raw_wa[a_][0][s_] = *(const u32x4*)(WA + rc_ * 128 + a_ * 64 + 32 * s_ + 8 * g); raw_wa[a_][1][s_] = *(const u32x4*)(WA + rp_ * 128 + a_ * 64 + 32 * s_ + 8 * g); } } while (0)
    const LAS unsigned char* cstg = cst + 32 * g;
#define CROW(k, off) (*(const LAS f32x4*)(cstg + ((k) * 256 + (off))))
    bf16_t* RW = (bf16_t*)(P.ws + WS_RW);
    u32x4 vprev[2] = {(u32x4){0u, 0u, 0u, 0u}, (u32x4){0u, 0u, 0u, 0u}}; float bon_prev = 0.f;
#define FINISH(cp) do { if ((cp) >= 1) { \
        lds_wait_ge(lds + CS_FLAGS + 40, (cp) + 1); lds_wait_ge(lds + CS_FLAGS + 44, (cp) + 1); \
        const LAS unsigned char* yb_ = lds + CS_YRING + ((cp) & 7) * YENT_BYTES + t * IMG_STRIDE + 16 * g; \
        float y_[16], v_[16]; unpack8(*(const LAS u32x4*)(yb_), y_); unpack8(*(const LAS u32x4*)(yb_ + 64), y_ + 8); unpack8(vprev[0], v_); unpack8(vprev[1], v_ + 8); \
        float s1_ = 0.f; _Pragma("unroll") for (int i_ = 0; i_ < 16; ++i_) s1_ += y_[i_]; \
        s1_ += __shfl_xor(s1_, 16); s1_ += __shfl_xor(s1_, 32); const float mean_ = s1_ * (1.f / 64.f); \
        float s2_ = 0.f; _Pragma("unroll") for (int i_ = 0; i_ < 16; ++i_) { y_[i_] -= mean_; s2_ += y_[i_] * y_[i_]; } \
        s2_ += __shfl_xor(s2_, 16); s2_ += __shfl_xor(s2_, 32); const float rstd_ = __builtin_amdgcn_rsqf(s2_ * (1.f / 64.f) + GN_EPS); \
        bf16_t* orow_ = RW + ((size_t)b * SEQ + 16 * ((cp) - 1) + t) * 1024 + h * 64 + 8 * g; \
        _Pragma("unroll") for (int s_ = 0; s_ < 2; ++s_) { float o_[8]; \
            const f32x4 w0_ = CROW(CK_LNW, 128 * s_), w1_ = CROW(CK_LNW, 128 * s_ + 16), b0_ = CROW(CK_LNB, 128 * s_), b1_ = CROW(CK_LNB, 128 * s_ + 16); \
            _Pragma("unroll") for (int e_ = 0; e_ < 8; ++e_) o_[e_] = y_[8 * s_ + e_] * rstd_ * (e_ < 4 ? w0_[e_] : w1_[e_ - 4]) + (e_ < 4 ? b0_[e_] : b1_[e_ - 4]) + bon_prev * v_[8 * s_ + e_]; \
            *(u32x4*)(orow_ + 32 * s_) = pack8(o_); } } } while (0)
    ISSUE_WA(pidx);
    int clast = -1;
    for (int c = pidx; c < NCHUNK; c += 6) {
        LAS unsigned char* slot = lds + (c & (NSLOT - 1)) * SLOT_BYTES;
        u32x4 raw_rkv[3][2][2];
        { const int tau_ = 16 * c + t; const size_t rc_ = scan_row(b, tau_), rp_ = scan_row(b, tau_ > 0 ? tau_ - 1 : 0);
#pragma unroll
          for (int s_ = 0; s_ < 2; ++s_)
#pragma unroll
            for (int a_ = 0; a_ < 3; ++a_) { raw_rkv[a_][0][s_] = *(const u32x4*)(RKV + rc_ * 3072 + a_ * 1024 + h * 64 + 32 * s_ + 8 * g); raw_rkv[a_][1][s_] = *(const u32x4*)(RKV + rp_ * 3072 + a_ * 1024 + h * 64 + 32 * s_ + 8 * g); } }
        if (c == 0 && t == 0) {
            const u32x4 zz4 = (u32x4){0u, 0u, 0u, 0u};
#pragma unroll
            for (int s_ = 0; s_ < 2; ++s_) { raw_rkv[0][1][s_] = zz4; raw_rkv[1][1][s_] = zz4; raw_rkv[2][1][s_] = zz4; raw_wa[0][1][s_] = zz4; raw_wa[1][1][s_] = zz4; }
        }
        bf16x8 twf[2], alf[2];
#pragma unroll
        for (int s = 0; s < 2; ++s) {
            float cu[8], pr[8], z[8];
            const int co = 128 * s;
            const f32x4 m0 = CROW(CK_MU_WL, co), m1 = CROW(CK_MU_WL, co + 16);
            unpack8(raw_wa[0][0][s], cu); unpack8(raw_wa[0][1][s], pr);
#pragma unroll
            for (int e = 0; e < 8; ++e) { const float zz = cu[e] + (pr[e] - cu[e]) * (e < 4 ? m0[e] : m1[e - 4]); const float ex = __builtin_amdgcn_exp2f(zz * (2.f * LOG2E)); z[e] = 1.f - 2.f * __builtin_amdgcn_rcpf(1.f + ex); }
            twf[s] = __builtin_bit_cast(bf16x8, pack8(z));
            const f32x4 n0 = CROW(CK_MU_AL, co), n1 = CROW(CK_MU_AL, co + 16);
            unpack8(raw_wa[1][0][s], cu); unpack8(raw_wa[1][1][s], pr);
#pragma unroll
            for (int e = 0; e < 8; ++e) z[e] = cu[e] + (pr[e] - cu[e]) * (e < 4 ? n0[e] : n1[e - 4]);
            alf[s] = __builtin_bit_cast(bf16x8, pack8(z));
        }
        if (c + 6 < NCHUNK) ISSUE_WA(c + 6);
        f32x4 accw[4], acca[4];
#pragma unroll
        for (int nt = 0; nt < 4; ++nt) { accw[nt] = fzero; acca[nt] = fzero;
#pragma unroll
            for (int s = 0; s < 2; ++s) {
                accw[nt] = MFMA32(twf[s], *(const LAS bf16x8*)(lds + CS_W2IMG + ((s * 4 + nt) * 64 + lane) * 16), accw[nt]);
                acca[nt] = MFMA32(alf[s], *(const LAS bf16x8*)(lds + CS_A2IMG + ((s * 4 + nt) * 64 + lane) * 16), acca[nt]);
            } }
        { unsigned long long pt0_ = 0ull; if (PROBE_PHASE == 22) pt0_ = __builtin_amdgcn_s_memrealtime();
          if (c >= NSLOT) { lds_wait_ge(lds + CS_FLAGS + 32, c - NSLOT + 1); lds_wait_ge(lds + CS_FLAGS + 36, c - NSLOT + 1); }
          if (PROBE_PHASE == 22) pticks += __builtin_amdgcn_s_memrealtime() - pt0_; }
#pragma unroll
        for (int nt = 0; nt < 4; ++nt)
#pragma unroll
            for (int r = 0; r < 4; ++r) {
                *(LAS float*)(slot + SL_SCR_W + (4 * g + r) * SCR_STRIDE + (16 * nt + t) * 4) = accw[nt][r];
                *(LAS float*)(slot + SL_SCR_A + (4 * g + r) * SCR_STRIDE + (16 * nt + t) * 4) = acca[nt][r];
            }
        asm volatile("s_waitcnt lgkmcnt(0)" ::: "memory");
        float wr[16], ar[16];
#pragma unroll
        for (int s = 0; s < 2; ++s)
#pragma unroll
            for (int q = 0; q < 2; ++q) {
                const f32x4 a = *(const LAS f32x4*)(slot + SL_SCR_W + t * SCR_STRIDE + (32 * s + 8 * g + 4 * q) * 4), bq = *(const LAS f32x4*)(slot + SL_SCR_A + t * SCR_STRIDE + (32 * s + 8 * g + 4 * q) * 4);
#pragma unroll
                for (int e = 0; e < 4; ++e) { wr[8 * s + 4 * q + e] = a[e]; ar[8 * s + 4 * q + e] = bq[e]; }
            }
        asm volatile("s_waitcnt lgkmcnt(0)" ::: "memory");
        __builtin_amdgcn_sched_barrier(0);
        FINISH(clast);
        __builtin_amdgcn_sched_barrier(0);
        float zr[16], zk[16]; u32x4 vnew[2];
#pragma unroll
        for (int s = 0; s < 2; ++s) {
            float cu[8], pr[8], z[8];
            const int co = 128 * s;
            const f32x4 r0 = CROW(CK_MU_R, co), r1 = CROW(CK_MU_R, co + 16);
            unpack8(raw_rkv[0][0][s], cu); unpack8(raw_rkv[0][1][s], pr);
#pragma unroll
            for (int e = 0; e < 8; ++e) zr[8 * s + e] = cu[e] + (pr[e] - cu[e]) * (e < 4 ? r0[e] : r1[e - 4]);
            const f32x4 k0 = CROW(CK_MU_K, co), k1 = CROW(CK_MU_K, co + 16);
            unpack8(raw_rkv[1][0][s], cu); unpack8(raw_rkv[1][1][s], pr);
#pragma unroll
            for (int e = 0; e < 8; ++e) zk[8 * s + e] = cu[e] + (pr[e] - cu[e]) * (e < 4 ? k0[e] : k1[e - 4]);
            const f32x4 v0 = CROW(CK_MU_V, co), v1 = CROW(CK_MU_V, co + 16);
            unpack8(raw_rkv[2][0][s], cu); unpack8(raw_rkv[2][1][s], pr);
#pragma unroll
            for (int e = 0; e < 8; ++e) z[e] = cu[e] + (pr[e] - cu[e]) * (e < 4 ? v0[e] : v1[e - 4]);
            vnew[s] = pack8(z);
            *(LAS u32x4*)(slot + SL_IMG_V + t * IMG_STRIDE + (32 * s + 8 * g) * 2) = vnew[s];
        }
        __builtin_amdgcn_sched_barrier(0);
        float ss = 0.f, bon = 0.f; float av[16];
#pragma unroll
        for (int s = 0; s < 2; ++s)
#pragma unroll
            for (int q = 0; q < 2; ++q) {
                const int co = 128 * s + 16 * q;
                const f32x4 c_a0 = CROW(CK_A0, co), c_kk = CROW(CK_KK, co), c_ka = CROW(CK_KA, co), c_rk = CROW(CK_RK, co);
#pragma unroll
                for (int e = 0; e < 4; ++e) { const int i = 8 * s + 4 * q + e;
                    const float a = sigmoidf_(c_a0[e] + ar[i]); av[i] = a;
                    const float kr_ = zk[i] * c_kk[e]; ss += kr_ * kr_;
                    bon += zr[i] * (zk[i] * (1.f + (a - 1.f) * c_ka[e])) * c_rk[e]; }
            }
        ss += __shfl_xor(ss, 16); ss += __shfl_xor(ss, 32); bon += __shfl_xor(bon, 16); bon += __shfl_xor(bon, 32);
        const float inv = 1.f / fmaxf(sqrtf(ss), 1e-12f);
        if (g == 0) *(LAS float*)(slot + SL_BON + t * 4) = bon;
        vprev[0] = vnew[0]; vprev[1] = vnew[1]; bon_prev = bon; clast = c;
        __builtin_amdgcn_sched_barrier(0);
        bf16x8 Af[2], Rf[2], Bf[2], Kf[2];
#pragma unroll
        for (int s = 0; s < 2; ++s) {
            float fa[8], fr_[8], fb[8], fk[8], gam[8];
#pragma unroll
            for (int q = 0; q < 2; ++q) {
                const int co = 128 * s + 16 * q;
                const f32x4 c_w0 = CROW(CK_W0, co), c_kk = CROW(CK_KK, co), c_ka = CROW(CK_KA, co);
#pragma unroll
                for (int e = 0; e < 4; ++e) { const int i = 8 * s + 4 * q + e, j = 4 * q + e;
                    const float lw = -0.6065306597126334f * sigmoidf_(c_w0[e] + wr[i]);
                    const float L = scan16(lw);
                    const float eL = __builtin_amdgcn_exp2f(L * LOG2E), ieL = __builtin_amdgcn_rcpf(eL), eLm = shr1_fill1(eL);
                    const float kk = zk[i] * c_kk[e] * inv, kp = zk[i] * (1.f + (av[i] - 1.f) * c_ka[e]);
                    fa[j] = -kk * eLm; fb[j] = kk * av[i] * ieL; fk[j] = kp * ieL; fr_[j] = zr[i] * eL; gam[j] = eL; }
            }
            const u32x4 pa = pack8(fa), pr = pack8(fr_), pb = pack8(fb), pk = pack8(fk);
            Af[s] = __builtin_bit_cast(bf16x8, pa); Rf[s] = __builtin_bit_cast(bf16x8, pr); Bf[s] = __builtin_bit_cast(bf16x8, pb); Kf[s] = __builtin_bit_cast(bf16x8, pk);
            const int off = t * IMG_STRIDE + (32 * s + 8 * g) * 2;
            *(LAS u32x4*)(slot + SL_IMG_A + off) = pa; *(LAS u32x4*)(slot + SL_IMG_R + off) = pr; *(LAS u32x4*)(slot + SL_IMG_B + off) = pb; *(LAS u32x4*)(slot + SL_IMG_K + off) = pk;
            if (t == 15) { *(LAS f32x4*)(slot + SL_GAM + (32 * s + 8 * g) * 4) = (f32x4){gam[0], gam[1], gam[2], gam[3]}; *(LAS f32x4*)(slot + SL_GAM + (32 * s + 8 * g + 4) * 4) = (f32x4){gam[4], gam[5], gam[6], gam[7]}; }
            __builtin_amdgcn_sched_barrier(0);
        }
        f32x4 nab = MFMA32(Bf[0], Af[0], fzero), nabT = MFMA32(Af[0], Bf[0], fzero), nak = MFMA32(Kf[0], Af[0], fzero), mbr = MFMA32(Bf[0], Rf[0], fzero), mkr = MFMA32(Kf[0], Rf[0], fzero);
        nab = MFMA32(Bf[1], Af[1], nab); nabT = MFMA32(Af[1], Bf[1], nabT); nak = MFMA32(Kf[1], Af[1], nak); mbr = MFMA32(Bf[1], Rf[1], mbr); mkr = MFMA32(Kf[1], Rf[1], mkr);
#pragma unroll
        for (int r = 0; r < 4; ++r) { const int s_ = 4 * g + r;
            if (!(s_ < t)) { nab[r] = 0.f; nak[r] = 0.f; }
            if (!(s_ <= t)) { mbr[r] = 0.f; mkr[r] = 0.f; }
            if (!(t < s_)) nabT[r] = 0.f; }
        const u32x2 z2 = (u32x2){0u, 0u};
#define FRG(x) mk_frag(pk4(x), z2)
        const bf16x8 fN = FRG(nab), fNT = FRG(nabT);
        const f32x4 n2 = MFMA32(fNT, fN, fzero), n2T = MFMA32(fN, fNT, fzero);
        const bf16x8 fN2 = FRG(n2), fN2T = FRG(n2T);
        const f32x4 n4 = MFMA32(fN2T, fN2, fzero), n4T = MFMA32(fN2, fN2T, fzero);
        const bf16x8 fN4 = FRG(n4), fN4T = FRG(n4T);
        const f32x4 n8T = MFMA32(fN4, fN4T, fzero);
        f32x4 q0 = nab;
#pragma unroll
        for (int r = 0; r < 4; ++r) if (4 * g + r == t) q0[r] += 1.f;
        const f32x4 q1 = MFMA32(fN2T, FRG(q0), q0);
        const f32x4 q2 = MFMA32(fN4T, FRG(q1), q1);
        const f32x4 tt = MFMA32(FRG(n8T), FRG(q2), q2);
#undef FRG
        *(LAS u32x2*)(slot + SL_NAK + lane * 8) = pk4(nak);
        *(LAS u32x2*)(slot + SL_TT + lane * 8) = pk4(tt);
        { const u32x2 a = pk4(mbr), bq = pk4(mkr); *(LAS u32x4*)(slot + SL_MT + lane * 16) = (u32x4){a.x, a.y, bq.x, bq.y}; }
        lds_flag_set(lds + CS_FLAGS + 4 * (c & (NSLOT - 1)), c + 1, lane);
    }
    FINISH(clast);
#undef FINISH
#undef ISSUE_WA
#undef CROW
    return pticks;
}

__device__ __forceinline__ unsigned long long scan_consumer(const Params& P, LAS unsigned char* lds, int b, int h, int wc, int lane) {
    unsigned long long pticks = 0ull;
#define PTICK_BEGIN(k) unsigned long long pt0_ = 0ull; if (PROBE_PHASE == (k)) pt0_ = __builtin_amdgcn_s_memrealtime()
#define PTICK_END(k) if (PROBE_PHASE == (k)) pticks += __builtin_amdgcn_s_memrealtime() - pt0_
    const int i16 = lane & 15, g = lane >> 4;
    const f32x4 fzero = (f32x4){0.f, 0.f, 0.f, 0.f};
    const u32x2 z2 = (u32x2){0u, 0u};
    f32x4 sacc[2][4];
#pragma unroll
    for (int n = 0; n < 2; ++n)
#pragma unroll
        for (int j = 0; j < 4; ++j) sacc[n][j] = fzero;
    __builtin_amdgcn_s_setprio(3);
    for (int c = 0; c < NCHUNK; ++c) {
        LAS unsigned char* slot = lds + (c & (NSLOT - 1)) * SLOT_BYTES;
        { PTICK_BEGIN(20); lds_wait_ge(lds + CS_FLAGS + 4 * (c & (NSLOT - 1)), c + 1); PTICK_END(20); }
        bf16x8 Af[2], Rf[2];
#pragma unroll
        for (int s = 0; s < 2; ++s) {
            const int off = i16 * IMG_STRIDE + (32 * s + 4 * g) * 2;
            Af[s] = mk_frag(*(const LAS u32x2*)(slot + SL_IMG_A + off), *(const LAS u32x2*)(slot + SL_IMG_A + off + 32));
            Rf[s] = mk_frag(*(const LAS u32x2*)(slot + SL_IMG_R + off), *(const LAS u32x2*)(slot + SL_IMG_R + off + 32));
        }
        const u32x2 nak = *(const LAS u32x2*)(slot + SL_NAK + lane * 8), ttf = *(const LAS u32x2*)(slot + SL_TT + lane * 8);
        const bf16x8 MTf = *(const LAS bf16x8*)(slot + SL_MT + lane * 16);
        const int troff = (4 * g + (i16 >> 2)) * IMG_STRIDE + (i16 & 3) * 8;
        bf16x8 BKf[4];
#pragma unroll
        for (int jt = 0; jt < 4; ++jt) BKf[jt] = mk_frag(lds_tr16(slot + SL_IMG_B + troff + jt * 32), lds_tr16(slot + SL_IMG_K + troff + jt * 32));
        u32x2 vt[2];
#pragma unroll
        for (int n = 0; n < 2; ++n) vt[n] = lds_tr16(slot + SL_IMG_V + troff + (2 * wc + n) * 32);
        f32x4 gm[4];
#pragma unroll
        for (int jt = 0; jt < 4; ++jt) gm[jt] = *(const LAS f32x4*)(slot + SL_GAM + (16 * jt + 4 * g) * 4);
        lds_flag_set(lds + CS_FLAGS + 32 + 4 * wc, c + 1, lane);
        f32x4 yacc[2];
#pragma unroll
        for (int n = 0; n < 2; ++n) {
            const bf16x8 S0 = mk_frag(pk4(sacc[n][0]), pk4(sacc[n][1])), S1 = mk_frag(pk4(sacc[n][2]), pk4(sacc[n][3]));
            f32x4 x = MFMA32(Af[0], S0, fzero); x = MFMA32(Af[1], S1, x); x = MFMA32(mk_frag(z2, nak), mk_frag(z2, vt[n]), x);
            const f32x4 u = MFMA32(mk_frag(ttf, z2), mk_frag(pk4(x), z2), fzero);
            const bf16x8 UV = mk_frag(pk4(u), vt[n]);
            f32x4 y = MFMA32(Rf[0], S0, fzero); y = MFMA32(Rf[1], S1, y); y = MFMA32(MTf, UV, y);
            yacc[n] = y;
#pragma unroll
            for (int jt = 0; jt < 4; ++jt) { const f32x4 sn = MFMA32(BKf[jt], UV, sacc[n][jt]); sacc[n][jt] = sn * gm[jt]; }
        }
        { LAS unsigned char* yb = lds + CS_YRING + (c & 7) * YENT_BYTES;
#pragma unroll
          for (int n = 0; n < 2; ++n)
#pragma unroll
            for (int r = 0; r < 4; ++r) *(LAS unsigned short*)(yb + (4 * g + r) * IMG_STRIDE + (16 * (2 * wc + n) + i16) * 2) = f2bf(yacc[n][r]); }
        lds_flag_set(lds + CS_FLAGS + 40 + 4 * wc, c + 1, lane);
    }
    __builtin_amdgcn_s_setprio(0);
    return pticks;
#undef PTICK_BEGIN
#undef PTICK_END
}

__device__ __forceinline__ unsigned long long scan_item_chunked(const Params& P, LAS unsigned char* lds, int item) {
    int tid_ = threadIdx.x; asm volatile("" : "+v"(tid_));
    const int tid = tid_, lane = tid & 63, wid = __builtin_amdgcn_readfirstlane(tid >> 6);
    const int b = item >> 4, h = item & 15;
    __syncthreads();
    {
        const int fs = tid >> 8, fnt = (tid >> 6) & 3, l = tid & 63;
        float f[8], f2[8];
#pragma unroll
        for (int e = 0; e < 8; ++e) { const size_t idx = (size_t)(32 * fs + 8 * (l >> 4) + e) * 1024 + h * 64 + 16 * fnt + (l & 15); f[e] = P.w2[idx]; f2[e] = P.a2[idx]; }
        *(LAS u32x4*)(lds + CS_W2IMG + tid * 16) = pack8(f); *(LAS u32x4*)(lds + CS_A2IMG + tid * 16) = pack8(f2);
    }
    if (tid < 64) {
        LAS float* cf = (LAS float*)(lds + CS_CONST); const int hj = h * 64 + tid;
        cf[CK_MU_R * 64 + tid] = P.mu[hj]; cf[CK_MU_K * 64 + tid] = P.mu[1024 + hj]; cf[CK_MU_V * 64 + tid] = P.mu[2048 + hj]; cf[CK_MU_WL * 64 + tid] = P.mu[3072 + tid]; cf[CK_MU_AL * 64 + tid] = P.mu[3136 + tid];
        cf[CK_W0 * 64 + tid] = P.w0[hj]; cf[CK_A0 * 64 + tid] = P.a0[hj]; cf[CK_KK * 64 + tid] = P.k_k[hj]; cf[CK_KA * 64 + tid] = P.k_a[hj]; cf[CK_RK * 64 + tid] = P.r_k[hj];
        cf[CK_LNW * 64 + tid] = P.ln_w[hj]; cf[CK_LNB * 64 + tid] = P.ln_b[hj];
        if (tid < 16) *(LAS int*)(lds + CS_FLAGS + 4 * tid) = 0;
    }
    __syncthreads();
    unsigned long long pticks = 0ull;
    if (wid < 2) pticks = scan_consumer(P, lds, b, h, wid, lane);
    else pticks = scan_producer(P, lds, b, h, wid - 2, lane);
    if (PROBE_PHASE == 22) { if (tid == 128) *(LAS unsigned long long*)(lds + CS_END) = pticks; }
    __syncthreads();
    if (PROBE_PHASE == 22) pticks = *(LAS unsigned long long*)(lds + CS_END);
    return pticks;
}

#define XB_TMO      128
#define XB_XCNT(j)  (256  + 64 * (j))
#define XB_XSUB(j)  (1280 + 64 * (j))
#define XB_XGEN(j)  (2304 + 64 * (j))
#define XB_TOP      3328
#define XB_TOPGEN   3392
#define XCD_BAR_WORDS 3456
#define XB_SPIN_CAP (1u << 18)
__device__ __forceinline__ unsigned xb_ld(unsigned* p)              { return __hip_atomic_load(p, __ATOMIC_RELAXED, __HIP_MEMORY_SCOPE_AGENT); }
__device__ __forceinline__ unsigned xb_add(unsigned* p, unsigned v) { return __hip_atomic_fetch_add(p, v, __ATOMIC_RELAXED, __HIP_MEMORY_SCOPE_AGENT); }
__device__ __forceinline__ unsigned xb_xcc_id() { return (unsigned)__builtin_amdgcn_s_getreg((3 << 11) | 20) & 0xFu; }
#define XB_SPIN(cond, bar) do { unsigned _sp = 0; while (cond) { __builtin_amdgcn_s_sleep(1); \
    if ((++_sp & 255u) == 0u) { if (xb_ld(&(bar)[XB_TMO])) break; if (_sp > XB_SPIN_CAP) { atomicAdd(&(bar)[XB_TMO], 1u); break; } } } } while (0)
struct XcdBarrier { unsigned* bar; unsigned x; volatile LAS unsigned* st; };
__device__ __forceinline__ XcdBarrier xcd_barrier_post(unsigned* bar, volatile LAS unsigned* st) {
    XcdBarrier b; b.bar = bar; b.x = xb_xcc_id(); b.st = st;
    if (threadIdx.x == 0) (void)xb_add(&bar[XB_XCNT(b.x)], 1u);
    return b;
}
__device__ __forceinline__ void xcd_barrier_complete(unsigned* bar, unsigned x, unsigned& nloc, unsigned& nx) {
    const unsigned G = gridDim.x * gridDim.y * gridDim.z;
    unsigned sum, cnt, mine, sp = 0u;
    for (;;) {
        sum = 0u; cnt = 0u; mine = 0u;
#pragma unroll
        for (unsigned j = 0; j < 16; ++j) { const unsigned c = xb_ld(&bar[XB_XCNT(j)]); sum += c; cnt += (c > 0u) ? 1u : 0u; mine = (j == x) ? c : mine; }
        if (sum == G) break;
        __builtin_amdgcn_s_sleep(1);
        if ((++sp & 255u) == 0u) { if (xb_ld(&bar[XB_TMO])) break; if (sp > XB_SPIN_CAP) { atomicAdd(&bar[XB_TMO], 1u); break; } }
    }
    nloc = mine > 0u ? mine : 1u; nx = cnt > 0u ? cnt : 1u;
}
__device__ __forceinline__ void xcd_barrier(const XcdBarrier& b) {
    asm volatile("s_waitcnt vmcnt(0)" ::: "memory");
    __syncthreads();
    if (threadIdx.x == 0) {
        unsigned* bar = b.bar;
        __builtin_amdgcn_s_waitcnt(0);
        unsigned nloc = b.st[0], nx = b.st[1];
        if (nloc == 0u) { xcd_barrier_complete(bar, b.x, nloc, nx); b.st[0] = nloc; b.st[1] = nx; }
        const unsigned old = xb_add(&bar[XB_XSUB(b.x)], 1u);
        const unsigned gen = old / nloc;
        if (old + 1u == (gen + 1u) * nloc) {
            __builtin_amdgcn_fence(__ATOMIC_RELEASE, "agent");
            asm volatile("s_waitcnt vmcnt(0)" ::: "memory");
            const unsigned og = xb_add(&bar[XB_TOP], 1u);
            const unsigned tg = og / nx;
            if (og + 1u == (tg + 1u) * nx) xb_add(&bar[XB_TOPGEN], 1u);
            else XB_SPIN(xb_ld(&bar[XB_TOPGEN]) == tg, bar);
            __builtin_amdgcn_fence(__ATOMIC_ACQUIRE, "agent");
            xb_add(&bar[XB_XGEN(b.x)], 1u);
            asm volatile("s_waitcnt vmcnt(0)" ::: "memory");
        } else {
            XB_SPIN(xb_ld(&bar[XB_XGEN(b.x)]) == gen, bar);
            __builtin_amdgcn_fence(__ATOMIC_ACQUIRE, "agent");
            asm volatile("s_waitcnt vmcnt(0)" ::: "memory");
        }
    }
    __syncthreads();
}

__device__ __forceinline__ void final_norm(const Params& P, int G) {
    int tid_ = threadIdx.x; asm volatile("" : "+v"(tid_));
    const int lane = tid_ & 63, gw = blockIdx.x * 8 + (tid_ >> 6), NGW = G * 8;
    const float* rowss = (const float*)(P.ws + WS_ROWSS);
    const f32x4* fw = (const f32x4*)P.fnw + lane;
    const f32x4 w0 = fw[0], w1 = fw[64], w2 = fw[128], w3 = fw[192];
    for (int r0 = gw * 2; r0 < MREAL; r0 += NGW * 2) {
        f32x4 v[2][4]; float rs[2];
#pragma unroll
        for (int k = 0; k < 2; ++k) { f32x4* o = (f32x4*)(P.out + (size_t)(r0 + k) * 1024) + lane; rs[k] = rowss[r0 + k];
#pragma unroll
            for (int j = 0; j < 4; ++j) v[k][j] = o[64 * j]; }
#pragma unroll
        for (int k = 0; k < 2; ++k) { f32x4* o = (f32x4*)(P.out + (size_t)(r0 + k) * 1024) + lane; const float rstd = __builtin_amdgcn_rsqf(rs[k] * (1.f / DM) + RMS_EPS);
            o[0] = v[k][0] * rstd * w0; o[64] = v[k][1] * rstd * w1; o[128] = v[k][2] * rstd * w2; o[192] = v[k][3] * rstd * w3; }
    }
}

__global__ void __launch_bounds__(512, 2) fwd_megakernel(Params P) {
    extern __shared__ __attribute__((aligned(16))) unsigned char lds_raw[];
    LAS unsigned char* lds = (LAS unsigned char*)lds_raw;
    cg::grid_group grid = cg::this_grid();
    const int G = gridDim.x;
    if (threadIdx.x < 16) ((LAS unsigned*)(lds + LDS_BARST))[threadIdx.x] = 0u;
    __syncthreads();
    const XcdBarrier bar = xcd_barrier_post((unsigned*)(P.ws + WS_CTL), (volatile LAS unsigned*)(lds + LDS_BARST));
    unsigned long long probe_wait = 0ull, probe_t0 = 0ull;
#define PROBE_BEGIN(k) do { if (PROBE_PHASE == (k)) probe_t0 = __builtin_amdgcn_s_memrealtime(); } while (0)
#define PROBE_END(k) do { if (PROBE_PHASE == (k)) probe_wait += __builtin_amdgcn_s_memrealtime() - probe_t0; } while (0)
    bf16_t* U = (bf16_t*)(P.ws + WS_U); bf16_t* Q = (bf16_t*)(P.ws + WS_Q); bf16_t* RW = (bf16_t*)(P.ws + WS_RW);
    const bf16_t* WinT = (const bf16_t*)(P.ws + WS_WIN); const bf16_t* WbT = (const bf16_t*)(P.ws + WS_WB); const bf16_t* WoT = (const bf16_t*)(P.ws + WS_WOUT);
    bf16_t* SG = (bf16_t*)P.out;
    constexpr int NG_P2 = 1536;
    PROBE_BEGIN(0);
    if (PHASE_MASK & 1) p0_prologue(P, lds, G);
    PROBE_END(0);
    __builtin_amdgcn_fence(__ATOMIC_SEQ_CST, "agent"); grid.sync(); __builtin_amdgcn_fence(__ATOMIC_SEQ_CST, "agent");
    PROBE_BEGIN(1);
    if (PHASE_MASK & 2) {
        pg8::Gemm g{U, U, WinT, 1024, 1 << 30};
        pg8::StaticOrder S; S.init(MPAD, NP1, G, (int)blockIdx.x);
        EpiP1 E{Q, (bf16_t*)(P.ws + WS_KV), (bf16_t*)(P.ws + WS_RKV), (bf16_t*)(P.ws + WS_WA), (const float*)(P.ws + WS_ROPE)};
        pg8::gemm_phase<EpiP1, pg8::StaticOrder, true>(lds, g, S, E);
    }
    PROBE_END(1);
    xcd_barrier(bar);
    PROBE_BEGIN(2);
    if (G == 256) {
        if (blockIdx.x < 128) { if (PHASE_MASK & 4) { const unsigned long long pt_ = scan_item_chunked(P, lds, blockIdx.x); if (PROBE_PHASE >= 20 && PROBE_PHASE < 30) probe_wait += pt_; } }
        else {
            if (PHASE_MASK & 8) for (int u = blockIdx.x - 128; u < 1024; u += 128) attn_unit(P, lds, u);
            __syncthreads();
            if (PHASE_MASK & 0x10) {
                pg8::Gemm g{U, U, WinT + (size_t)(NP1 + 2048) * 1024, 1024, 1 << 30};
                pg8::StaticOrder S; S.init(MREAL, 2048, 128, (int)blockIdx.x - 128); S.range(0, NG_P2);
                EpiGate E{Q, RW, SG, 8};
                pg8::gemm_phase<EpiGate, pg8::StaticOrder, true>(lds, g, S, E);
            }
        }
    } else {
        for (int it = blockIdx.x; it < 128 + 1024; it += G) { if (it < 128) { if (PHASE_MASK & 4) scan_item_chunked(P, lds, it); } else { if (PHASE_MASK & 8) attn_unit(P, lds, it - 128); } }
    }
    PROBE_END(2);
    xcd_barrier(bar);
    PROBE_BEGIN(3);
    if (PHASE_MASK & 0x10) {
        {
            pg8::Gemm g{U, U, WinT + (size_t)(NP1 + 2048) * 1024, 1024, 1 << 30};
            pg8::StaticOrder S; S.init(MREAL, 2048, G, (int)blockIdx.x); S.range(G == 256 ? NG_P2 : 0, 2048);
            EpiGate E{Q, RW, SG, 8};
            pg8::gemm_phase<EpiGate, pg8::StaticOrder, true>(lds, g, S, E);
        }
        {
            pg8::Gemm g{U, U, WinT + (size_t)NP1 * 1024, 1024, 1 << 30};
            pg8::StaticOrder S; S.init(MREAL, 2048, G, (int)blockIdx.x);
            EpiGate E{Q, RW, SG, 0};
            pg8::gemm_phase<EpiGate, pg8::StaticOrder, true>(lds, g, S, E);
        }
    }
    PROBE_END(3);
    xcd_barrier(bar);
    PROBE_BEGIN(4);
    if (PHASE_MASK & 0x20) {
        pg8::Gemm g{Q, Q, WbT, 1024, 1 << 30};
        pg8::StaticOrder S; S.init(MREAL, 1024, G, (int)blockIdx.x);
        EpiBranch E{U, SG, 0};
        pg8::gemm_phase<EpiBranch, pg8::StaticOrder, true>(lds, g, S, E);
    }
    xcd_barrier(bar);
    if (PHASE_MASK & 0x20) {
        pg8::Gemm g{RW, RW, WbT + (size_t)1024 * 1024, 1024, 1 << 30};
        pg8::StaticOrder S; S.init(MREAL, 1024, G, (int)blockIdx.x);
        EpiBranch E{U, SG, 4};
        pg8::gemm_phase<EpiBranch, pg8::StaticOrder, true>(lds, g, S, E);
    }
    PROBE_END(4);
    xcd_barrier(bar);
    PROBE_BEGIN(5);
    if (PHASE_MASK & 0x40) {
        pg8::Gemm g{U, U, WoT, 1024, 1 << 30};
        pg8::StaticOrder S; S.init(MREAL, 1024, G, (int)blockIdx.x);
        EpiOut E{P.x, P.out, (float*)(P.ws + WS_ROWSS)};
        pg8::gemm_phase<EpiOut, pg8::StaticOrder, true>(lds, g, S, E);
    }
    PROBE_END(5);
    xcd_barrier(bar);
    PROBE_BEGIN(6);
    if (PHASE_MASK & 0x80) final_norm(P, G);
    PROBE_END(6);
    if (PROBE_PHASE >= 0 && blockIdx.x == PROBE_BLOCK && threadIdx.x == 0) {
        const unsigned long long t = __builtin_amdgcn_s_memrealtime();
        while (__builtin_amdgcn_s_memrealtime() - t < probe_wait) __builtin_amdgcn_s_sleep(8);
    }
}

extern "C" void kernel_launch(void* const* d_in, const int* in_sizes, int n_in, void* d_out, int out_size, void* d_ws, size_t ws_size, hipStream_t stream) {
    static int grid = 0;
    if (grid == 0) {
        if (n_in != 19 || in_sizes[0] != MREAL * DM || out_size != MREAL * DM || ws_size < WS_END) {
            fprintf(stderr, "kernel_launch: unexpected shapes (n_in %d, in0 %d, out %d, ws %zu); nothing launched\n", n_in, n_in > 0 ? in_sizes[0] : -1, out_size, ws_size); grid = -1; return; }
        int dev = 0, cus = 0, per_cu = 0;
        hipGetDevice(&dev);
        hipDeviceGetAttribute(&cus, hipDeviceAttributeMultiprocessorCount, dev);
        hipFuncSetAttribute((const void*)fwd_megakernel, hipFuncAttributeMaxDynamicSharedMemorySize, LDS_BYTES);
        hipOccupancyMaxActiveBlocksPerMultiprocessor(&per_cu, (const void*)fwd_megakernel, 512, LDS_BYTES);
        if (per_cu < 1) { fprintf(stderr, "kernel_launch: occupancy query says %d blocks per CU\n", per_cu); per_cu = 1; }
        grid = cus * 1;
        if (grid > 256) grid = 256;
        (void)hipGetLastError();
    }
    if (grid < 0) return;
    if (hipMemsetAsync((char*)d_ws + WS_CTL, 0, CTL_ZERO_BYTES, stream) != hipSuccess) { fprintf(stderr, "kernel_launch: hipMemsetAsync failed\n"); return; }
    Params p{};
    p.x = (const float*)d_in[0]; p.meta = (const float*)d_in[1]; p.norm_w = (const float*)d_in[2]; p.w_in = (const float*)d_in[3]; p.sinks = (const float*)d_in[4];
    p.mu = (const float*)d_in[5]; p.w0 = (const float*)d_in[6]; p.w2 = (const float*)d_in[7]; p.a0 = (const float*)d_in[8]; p.a2 = (const float*)d_in[9];
    p.k_k = (const float*)d_in[10]; p.k_a = (const float*)d_in[11]; p.r_k = (const float*)d_in[12]; p.ln_w = (const float*)d_in[13]; p.ln_b = (const float*)d_in[14];
    p.w_ba = (const float*)d_in[15]; p.w_br = (const float*)d_in[16]; p.w_out = (const float*)d_in[17]; p.fnw = (const float*)d_in[18];
    p.out = (float*)d_out; p.ws = (unsigned char*)d_ws;
    void* args[] = {&p};
    hipError_t e = hipLaunchCooperativeKernel((const void*)fwd_megakernel, dim3(grid), dim3(512), args, LDS_BYTES, stream);
    if (e != hipSuccess) fprintf(stderr, "cooperative launch failed: %s (grid %d)\n", hipGetErrorString(e), grid);
}
```

```cpp
#include <hip/hip_runtime.h>
#include <hip/hip_cooperative_groups.h>
#include <cstdio>
#include <cstdint>
namespace cg = cooperative_groups;
#ifndef PROBE_PHASE
#define PROBE_PHASE -1
#endif
#ifndef PROBE_BLOCK
#define PROBE_BLOCK 0
#endif
#ifndef PHASE_MASK
#define PHASE_MASK 0xFF
#endif

#define LAS __attribute__((address_space(3)))
typedef unsigned short bf16_t;
typedef short bf16x8 __attribute__((ext_vector_type(8)));
typedef short s16x4 __attribute__((ext_vector_type(4)));
typedef float f32x4 __attribute__((ext_vector_type(4)));
typedef float f32x16 __attribute__((ext_vector_type(16)));
typedef unsigned u32x4 __attribute__((ext_vector_type(4)));
typedef unsigned u32x2 __attribute__((ext_vector_type(2)));

constexpr int DM = 1024, NB = 8, SEQ = 8192, NMETA = 16, TT = SEQ + NMETA;
constexpr int MREAL = NB * SEQ;
constexpr int MPAD = MREAL + 256;
constexpr int NIN_SRC = 8576, NIN = 8704;
constexpr int NP1 = 4608;
constexpr float RMS_EPS = 1e-6f, GN_EPS = 64e-5f;
constexpr float LOG2E = 1.4426950408889634f;
constexpr float QSCALE = 0.125f * LOG2E;

constexpr size_t MiB = 1u << 20;
constexpr size_t WS_CTL = 0, CTL_ZERO_BYTES = 1 * MiB;
constexpr size_t WS_ROWSS = 512 * 1024;
constexpr size_t WS_WIN = 1 * MiB;
constexpr size_t WS_WB = 18 * MiB;
constexpr size_t WS_WOUT = 22 * MiB;
constexpr size_t WS_ROPE = 24 * MiB;
constexpr size_t WS_U = 27 * MiB;
constexpr size_t WS_Q = 156 * MiB;
constexpr size_t WS_KV = 285 * MiB;
constexpr size_t WS_RKV = 318 * MiB;
constexpr size_t WS_WA = 704 * MiB;
constexpr size_t WS_RW = 721 * MiB;
constexpr size_t WS_END = 849 * MiB;

constexpr int LDS_STAGE = 131072;
constexpr int LDS_BARST = 163840 - 64;
constexpr int LDS_BYTES = 163840;

typedef float f32x2_t __attribute__((ext_vector_type(2))); typedef __bf16 bf16x2_t __attribute__((ext_vector_type(2)));
__device__ __forceinline__ unsigned cvt_pk_bf16(float lo, float hi) { const f32x2_t v = {lo, hi}; const bf16x2_t b = __builtin_convertvector(v, bf16x2_t); return __builtin_bit_cast(unsigned, b); }
__device__ __forceinline__ float bf2f(unsigned short b) { return __uint_as_float((unsigned)b << 16); }
__device__ __forceinline__ float bflo(unsigned w) { return __uint_as_float(w << 16); }
__device__ __forceinline__ float bfhi(unsigned w) { return __uint_as_float(w & 0xffff0000u); }
__device__ __forceinline__ unsigned short f2bf(float f) { return (unsigned short)(cvt_pk_bf16(f, 0.f) & 0xffffu); }
__device__ __forceinline__ float wave_sum(float v) {
#pragma unroll
    for (int o = 1; o < 64; o <<= 1) v += __shfl_xor(v, o);
    return v;
}
template <int CTRL> __device__ __forceinline__ float dppf(float v) {
    return __builtin_bit_cast(float, __builtin_amdgcn_update_dpp(0, __builtin_bit_cast(int, v), CTRL, 0xF, 0xF, true));
}
__device__ __forceinline__ float red8(float v) {
    v += dppf<0xB1>(v);
    v += dppf<0x4E>(v);
    v += dppf<0x141>(v);
    return v;
}
__device__ __forceinline__ float sigmoidf_(float x) { return __builtin_amdgcn_rcpf(1.f + __builtin_amdgcn_exp2f(-x * LOG2E)); }
__device__ __forceinline__ float siluf_(float x) { return x * sigmoidf_(x); }

namespace pg8 {
constexpr int BM = 256, BK = 64, HALF = 128, HTB = HALF * BK * 2, STAGE_BYTES = 8 * HTB, NXCD = 8, WGM = 8;
__host__ __device__ __forceinline__ int lds_byte(int r, int c) { const int st = (r >> 4) * 2 + (c >> 5), rr = r & 15, cc = c & 31, ob = rr * 64 + cc * 2; return st * 1024 + (ob ^ (((ob >> 9) & 1) << 5)); }
__host__ __device__ __forceinline__ void stage_rc(int b, int& R, int& C) { const int st = b / 1024, sb = b % 1024, swz = sb ^ (((sb >> 9) & 1) << 5); R = (st >> 1) * 16 + swz / 64; C = (st & 1) * 32 + (swz % 64) / 2; }
__host__ __device__ __forceinline__ int perm32(int rho) { const int n = rho >> 4, i = rho & 15; return 8 * (i >> 2) + 4 * n + (i & 3); }

struct Unit { int pm, pn; };
struct Gemm { const bf16_t* A; const bf16_t* A2; const bf16_t* Bt; int K; int asplit; };

struct StaticOrder {
    int nM, nN, nwg, G, c, L0, L1;
    __device__ void init(int M, int N, int G_, int c_) { nM = M / BM; nN = N / BM; nwg = nM * nN; G = G_; c = c_; L0 = 0; L1 = nwg; asm volatile("" : "+s"(L1)); }
    __device__ void range(int a, int b) { L0 = a; L1 = b; asm volatile("" : "+s"(L1)); }
    __device__ bool next(int i, Unit& u) const {
        const long L = (long)L0 + (long)i * G + c; if (L >= L1) return false;
        int wgid = (int)L; { const int q = nwg / NXCD, r = nwg % NXCD, xcd = wgid % NXCD, off = wgid / NXCD; wgid = (xcd < r ? xcd * (q + 1) : r * (q + 1) + (xcd - r) * q) + off; }
        const int nig = WGM * nN, gid = wgid / nig, fm = gid * WGM, gsz = (nM - fm) < WGM ? (nM - fm) : WGM;
        u.pm = fm + ((wgid % nig) % gsz); u.pn = (wgid % nig) / gsz; return true;
    }
};
template <class Epi, class Sched, bool ALIGN_EPI>
__device__ __forceinline__ void gemm_phase(LAS unsigned char* lds, const Gemm g, const Sched& S, const Epi& E) {
    int tid_ = threadIdx.x; asm volatile("" : "+v"(tid_));
    const int tid = tid_, wid = __builtin_amdgcn_readfirstlane(tid >> 6), lane = tid & 63, wr = wid >> 2, wc = wid & 3, fr = lane & 15, fq = lane >> 4;
    const int K = g.K, nt = K / BK;
    unsigned voffA[2], voffB[2];
#pragma unroll
    for (int i = 0; i < 2; ++i) { int R, C; stage_rc(tid * 16 + i * 8192, R, C); const int Rb = Epi::PERM ? ((R & ~31) + perm32(R & 31)) : R;
        voffA[i] = (unsigned)(R * K + C) * 2u; voffB[i] = (unsigned)(Rb * K + C) * 2u; }
    const size_t kstep = (size_t)(BK * 2);
    const size_t hstep = (size_t)HALF * K * 2;
    const size_t tstep = 2 * hstep;
    const unsigned ldsw = (unsigned)wid * 1024u;
    const int aoff = lds_byte(wr * 64 + fr, fq * 8), boff = lds_byte(wc * 32 + fr, fq * 8);
#define PG8_SA(b, h) (((b) * 2 + (h)) * HTB)
#define PG8_SB(b, h) ((4 + (b) * 2 + (h)) * HTB)
#define PG8_STAGE(bufoff, gbase, voff) do { _Pragma("unroll") for (int _i = 0; _i < 2; ++_i) \
        __builtin_amdgcn_global_load_lds((const unsigned*)((const char*)(gbase) + (voff)[_i]), (LAS unsigned*)(lds + (bufoff) + ldsw + _i * 8192), 16, 0, 0); } while (0)
#define PG8_LDA(dst, b, h) do { _Pragma("unroll") for (int m = 0; m < 4; ++m) _Pragma("unroll") for (int k = 0; k < 2; ++k) dst[m][k] = *(const LAS bf16x8*)(lds + PG8_SA(b, h) + aoff + m * 2048 + k * 1024); } while (0)
#define PG8_LDB(dst, b, h) do { _Pragma("unroll") for (int n = 0; n < 2; ++n) _Pragma("unroll") for (int k = 0; k < 2; ++k) dst[n][k] = *(const LAS bf16x8*)(lds + PG8_SB(b, h) + boff + n * 2048 + k * 1024); } while (0)
#define PG8_MMA(ai, bj, At, Bt) do { __builtin_amdgcn_s_setprio(1); _Pragma("unroll") for (int m = 0; m < 4; ++m) _Pragma("unroll") for (int n = 0; n < 2; ++n) _Pragma("unroll") for (int k = 0; k < 2; ++k) \
        acc[ai][bj][m][n] = __builtin_amdgcn_mfma_f32_16x16x32_bf16(Bt[n][k], At[m][k], acc[ai][bj][m][n], 0, 0, 0); __builtin_amdgcn_s_setprio(0); } while (0)
#define PG8_WAIT_V(n) asm volatile("s_waitcnt vmcnt(" #n ")" ::: "memory")
#define PG8_WAIT_L(n) asm volatile("s_waitcnt lgkmcnt(" #n ")" ::: "memory")
#define PG8_BAR __builtin_amdgcn_s_barrier()
#define PG8_SCHED __builtin_amdgcn_sched_barrier(0)
#define PG8_APTR(u) ((const char*)((u).pn >= g.asplit ? g.A2 : g.A) + (size_t)(u).pm * tstep)
#define PG8_BPTR(u) ((const char*)g.Bt + (size_t)(u).pn * tstep)
    Unit cur, nxt; int ui = 0;
    if (!S.next(0, cur)) return;
    f32x4 acc[2][2][4][2];
#pragma unroll
    for (int a = 0; a < 2; ++a)
#pragma unroll
        for (int b = 0; b < 2; ++b)
#pragma unroll
            for (int m = 0; m < 4; ++m)
#pragma unroll
                for (int n = 0; n < 2; ++n) acc[a][b][m][n] = (f32x4){0.f, 0.f, 0.f, 0.f};
    bf16x8 At[4][2], B0[2][2], B1[2][2];
    const char* cA = PG8_APTR(cur); const char* cB = PG8_BPTR(cur);
    PG8_STAGE(PG8_SB(0, 0), cB, voffB); PG8_STAGE(PG8_SB(0, 1), cB + hstep, voffB); PG8_STAGE(PG8_SA(0, 0), cA, voffA); PG8_STAGE(PG8_SA(0, 1), cA + hstep, voffA);
    if (wr == 1) PG8_BAR;
    PG8_WAIT_V(2); PG8_BAR;
    PG8_STAGE(PG8_SB(1, 0), cB + kstep, voffB); PG8_STAGE(PG8_SA(1, 0), cA + kstep, voffA); PG8_STAGE(PG8_SB(1, 1), cB + hstep + kstep, voffB);
    PG8_WAIT_V(6); PG8_BAR;
    for (;;) {
        const bool has_next = S.next(ui + 1, nxt);
        const char* nA = has_next ? PG8_APTR(nxt) : cA; const char* nB = has_next ? PG8_BPTR(nxt) : cB;
        for (int t = 0; t < nt; t += 2) {
            const bool last = (t == nt - 2);
            const char* a1 = cA + (size_t)(t + 1) * kstep;
            const char* a2 = last ? nA : cA + (size_t)(t + 2) * kstep; const char* b2 = last ? nB : cB + (size_t)(t + 2) * kstep;
            const char* a3 = a2 + kstep; const char* b3 = b2 + kstep;
            PG8_LDB(B0, 0, 0); PG8_LDB(B1, 0, 1); PG8_SCHED; PG8_LDA(At, 0, 0); PG8_STAGE(PG8_SA(1, 1), a1 + hstep, voffA);
            PG8_WAIT_V(8); PG8_WAIT_L(0); PG8_BAR; PG8_MMA(0, 0, At, B0); PG8_MMA(0, 1, At, B1); PG8_BAR; PG8_SCHED;
            PG8_LDA(At, 0, 1); PG8_STAGE(PG8_SB(0, 0), b2, voffB); PG8_STAGE(PG8_SB(0, 1), b2 + hstep, voffB); PG8_STAGE(PG8_SA(0, 0), a2, voffA);
            PG8_WAIT_V(8); PG8_WAIT_L(0); PG8_BAR; PG8_MMA(1, 0, At, B0); PG8_MMA(1, 1, At, B1); PG8_BAR; PG8_SCHED;
            PG8_LDB(B0, 1, 0); PG8_LDB(B1, 1, 1); PG8_SCHED; PG8_LDA(At, 1, 0); PG8_STAGE(PG8_SA(0, 1), a2 + hstep, voffA);
            PG8_WAIT_V(8); PG8_WAIT_L(0); PG8_BAR; PG8_MMA(0, 0, At, B0); PG8_MMA(0, 1, At, B1); PG8_BAR; PG8_SCHED;
            PG8_LDA(At, 1, 1); PG8_STAGE(PG8_SB(1, 0), b3, voffB); PG8_STAGE(PG8_SB(1, 1), b3 + hstep, voffB); PG8_STAGE(PG8_SA(1, 0), a3, voffA);
            PG8_WAIT_V(8); PG8_WAIT_L(0); PG8_BAR; PG8_MMA(1, 0, At, B0); PG8_MMA(1, 1, At, B1); PG8_BAR; PG8_SCHED;
        }
        if constexpr (ALIGN_EPI) { if (wr == 0) PG8_BAR; }
        E(acc, cur, wr, wc, fr, fq);
        if (!has_next) break;
#pragma unroll
        for (int a = 0; a < 2; ++a)
#pragma unroll
            for (int b = 0; b < 2; ++b)
#pragma unroll
                for (int m = 0; m < 4; ++m)
#pragma unroll
                    for (int n = 0; n < 2; ++n) acc[a][b][m][n] = (f32x4){0.f, 0.f, 0.f, 0.f};
        cur = nxt; cA = nA; cB = nB; ++ui;
        if constexpr (ALIGN_EPI) { if (wr == 1) PG8_BAR; }
    }
    PG8_WAIT_V(0);
    if constexpr (!ALIGN_EPI) { if (wr == 0) PG8_BAR; }
    PG8_BAR;
#undef PG8_SA
#undef PG8_SB
#undef PG8_STAGE
#undef PG8_LDA
#undef PG8_LDB
#undef PG8_MMA
#undef PG8_WAIT_V
#undef PG8_WAIT_L
#undef PG8_BAR
#undef PG8_SCHED
#undef PG8_APTR
#undef PG8_BPTR
}
}

struct Params {
    const float* x; const float* meta; const float* norm_w; const float* w_in; const float* sinks; const float* mu; const float* w0; const float* w2;
    const float* a0; const float* a2; const float* k_k; const float* k_a; const float* r_k; const float* ln_w; const float* ln_b;
    const float* w_ba; const float* w_br; const float* w_out; const float* fnw;
    float* out; unsigned char* ws;
};

struct EpiP1 {
    static constexpr bool PERM = true;
    bf16_t *Q, *KV, *RKV, *WA; const float* rope;
    __device__ __forceinline__ void operator()(const f32x4 (&acc)[2][2][4][2], const pg8::Unit& u, int wr, int wc, int fr, int fq) const {
        asm volatile("" : "+v"(fr), "+v"(fq));
        const int pn = u.pn, row0 = u.pm * 256 + wr * 64 + fr, cl = wc * 32 + 8 * fq;
        if (pn <= 4) {
            const float sc = pn < 4 ? QSCALE : 1.f;
#pragma unroll
            for (int ai = 0; ai < 2; ++ai)
#pragma unroll
                for (int m = 0; m < 4; ++m) {
                    const int row = row0 + ai * 128 + m * 16;
                    const int pos = row < MREAL ? (row & (SEQ - 1)) + NMETA : row - MREAL;
                    const float* rp = rope + (size_t)pos * 64;
#pragma unroll
                    for (int bj = 0; bj < 2; ++bj) {
                        const int col = bj * 128 + cl;
                        f32x4 v0 = acc[ai][bj][m][0], v1 = acc[ai][bj][m][1];
                        u32x4 w;
                        if (pn == 4 && bj == 1) {
                            w.x = cvt_pk_bf16(v0[0], v0[1]); w.y = cvt_pk_bf16(v0[2], v0[3]); w.z = cvt_pk_bf16(v1[0], v1[1]); w.w = cvt_pk_bf16(v1[2], v1[3]);
                        } else {
                            const int i0 = (col & 63) >> 1;
                            const f32x4 c = *(const f32x4*)(rp + i0), s = *(const f32x4*)(rp + 32 + i0);
                            w.x = cvt_pk_bf16((v0[0] * c[0] - v0[1] * s[0]) * sc, (v0[1] * c[0] + v0[0] * s[0]) * sc);
                            w.y = cvt_pk_bf16((v0[2] * c[1] - v0[3] * s[1]) * sc, (v0[3] * c[1] + v0[2] * s[1]) * sc);
                            w.z = cvt_pk_bf16((v1[0] * c[2] - v1[1] * s[2]) * sc, (v1[1] * c[2] + v1[0] * s[2]) * sc);
                            w.w = cvt_pk_bf16((v1[2] * c[3] - v1[3] * s[3]) * sc, (v1[3] * c[3] + v1[2] * s[3]) * sc);
                        }
                        bf16_t* dst = pn < 4 ? Q + (size_t)row * 1024 + pn * 256 + col : KV + (size_t)row * 256 + col;
                        *(u32x4*)dst = w;
                    }
                }
        } else {
#pragma unroll
            for (int ai = 0; ai < 2; ++ai)
#pragma unroll
                for (int m = 0; m < 4; ++m) {
                    const int row = row0 + ai * 128 + m * 16;
#pragma unroll
                    for (int bj = 0; bj < 2; ++bj) {
                        const int col = bj * 128 + cl;
                        const f32x4 v0 = acc[ai][bj][m][0], v1 = acc[ai][bj][m][1];
                        u32x4 w; w.x = cvt_pk_bf16(v0[0], v0[1]); w.y = cvt_pk_bf16(v0[2], v0[3]); w.z = cvt_pk_bf16(v1[0], v1[1]); w.w = cvt_pk_bf16(v1[2], v1[3]);
                        if (pn < 17) *(u32x4*)(RKV + (size_t)row * 3072 + (pn - 5) * 256 + col) = w;
                        else if (bj == 0) *(u32x4*)(WA + (size_t)row * 128 + col) = w;
                    }
                }
        }
    }
};
struct EpiGate {
    static constexpr bool PERM = true;
    bf16_t *Q, *RW, *SG; int pn_off;
    __device__ __forceinline__ void operator()(const f32x4 (&acc)[2][2][4][2], const pg8::Unit& u, int wr, int wc, int fr, int fq) const {
        asm volatile("" : "+v"(fr), "+v"(fq));
        const int pn = u.pn + pn_off, row0 = u.pm * 256 + wr * 64 + fr, cl = wc * 32 + 8 * fq;
#pragma unroll
        for (int ai = 0; ai < 2; ++ai)
#pragma unroll
            for (int m = 0; m < 4; ++m) {
                const int row = row0 + ai * 128 + m * 16;
#pragma unroll
                for (int bj = 0; bj < 2; ++bj) {
                    const int col = bj * 128 + cl;
                    const f32x4 v0 = acc[ai][bj][m][0], v1 = acc[ai][bj][m][1];
                    u32x4 w;
                    if (pn < 8) {
                        bf16_t* p = (pn < 4 ? Q + (size_t)row * 1024 + pn * 256 : RW + (size_t)row * 1024 + (pn - 4) * 256) + col;
                        const u32x4 a = *(const u32x4*)p;
                        w.x = cvt_pk_bf16(bflo(a.x) * siluf_(v0[0]), bfhi(a.x) * siluf_(v0[1]));
                        w.y = cvt_pk_bf16(bflo(a.y) * siluf_(v0[2]), bfhi(a.y) * siluf_(v0[3]));
                        w.z = cvt_pk_bf16(bflo(a.z) * siluf_(v1[0]), bfhi(a.z) * siluf_(v1[1]));
                        w.w = cvt_pk_bf16(bflo(a.w) * siluf_(v1[2]), bfhi(a.w) * siluf_(v1[3]));
                        *(u32x4*)p = w;
                    } else {
                        w.x = cvt_pk_bf16(sigmoidf_(v0[0]), sigmoidf_(v0[1])); w.y = cvt_pk_bf16(sigmoidf_(v0[2]), sigmoidf_(v0[3]));
                        w.z = cvt_pk_bf16(sigmoidf_(v1[0]), sigmoidf_(v1[1])); w.w = cvt_pk_bf16(sigmoidf_(v1[2]), sigmoidf_(v1[3]));
                        *(u32x4*)(SG + (size_t)row * 2048 + (pn - 8) * 256 + col) = w;
                    }
                }
                asm volatile("" ::: "memory");
            }
    }
};
struct EpiBranch {
    static constexpr bool PERM = true;
    bf16_t* MG; const bf16_t* SG; int pn_off;
    __device__ __forceinline__ void operator()(const f32x4 (&acc)[2][2][4][2], const pg8::Unit& u, int wr, int wc, int fr, int fq) const {
        asm volatile("" : "+v"(fr), "+v"(fq));
        const int pn = u.pn + pn_off, pc = pn & 3, row0 = u.pm * 256 + wr * 64 + fr, cl = wc * 32 + 8 * fq;
        const unsigned so0 = (unsigned)row0 * 2048u + (unsigned)((pn >= 4 ? 1024 : 0) + pc * 256 + cl), mo0 = (unsigned)row0 * 1024u + (unsigned)(pc * 256 + cl);
#pragma unroll
        for (int ai = 0; ai < 2; ++ai)
#pragma unroll
            for (int mh = 0; mh < 2; ++mh) {
                u32x4 sg[2][2], pa[2][2];
#pragma unroll
                for (int mm = 0; mm < 2; ++mm)
#pragma unroll
                    for (int bj = 0; bj < 2; ++bj) { const int m = 2 * mh + mm;
                        sg[mm][bj] = *(const u32x4*)(SG + (so0 + (unsigned)((ai * 128 + m * 16) * 2048 + bj * 128)));
                        if (pn >= 4) pa[mm][bj] = *(const u32x4*)(MG + (mo0 + (unsigned)((ai * 128 + m * 16) * 1024 + bj * 128))); else pa[mm][bj] = (u32x4){0u, 0u, 0u, 0u}; }
#pragma unroll
                for (int mm = 0; mm < 2; ++mm)
#pragma unroll
                    for (int bj = 0; bj < 2; ++bj) { const int m = 2 * mh + mm;
                        const f32x4 v0 = acc[ai][bj][m][0], v1 = acc[ai][bj][m][1]; const u32x4 sv = sg[mm][bj], a = pa[mm][bj];
                        u32x4 w;
                        w.x = cvt_pk_bf16(bflo(sv.x) * v0[0] + bflo(a.x), bfhi(sv.x) * v0[1] + bfhi(a.x));
                        w.y = cvt_pk_bf16(bflo(sv.y) * v0[2] + bflo(a.y), bfhi(sv.y) * v0[3] + bfhi(a.y));
                        w.z = cvt_pk_bf16(bflo(sv.z) * v1[0] + bflo(a.z), bfhi(sv.z) * v1[1] + bfhi(a.z));
                        w.w = cvt_pk_bf16(bflo(sv.w) * v1[2] + bflo(a.w), bfhi(sv.w) * v1[3] + bfhi(a.w));
                        *(u32x4*)(MG + (mo0 + (unsigned)((ai * 128 + m * 16) * 1024 + bj * 128))) = w;
                    }
                asm volatile("" ::: "memory");
            }
    }
};
struct EpiOut {
    static constexpr bool PERM = false;
    const float* x; float* out; float* rowss;
    __device__ __forceinline__ void operator()(const f32x4 (&acc)[2][2][4][2], const pg8::Unit& u, int wr, int wc, int fr, int fq) const {
        asm volatile("" : "+v"(fr), "+v"(fq));
        const int row0 = u.pm * 256 + wr * 64 + fr, col0 = u.pn * 256 + wc * 32 + 4 * fq;
        const unsigned xo0 = (unsigned)row0 * 1024u + (unsigned)col0;
#pragma unroll
        for (int ai = 0; ai < 2; ++ai)
#pragma unroll
            for (int mh = 0; mh < 2; ++mh) {
                f32x4 xl[2][2][2];
#pragma unroll
                for (int mm = 0; mm < 2; ++mm)
#pragma unroll
                    for (int bj = 0; bj < 2; ++bj)
#pragma unroll
                        for (int n = 0; n < 2; ++n) xl[mm][bj][n] = *(const f32x4*)(x + (xo0 + (unsigned)((ai * 128 + (2 * mh + mm) * 16) * 1024 + bj * 128 + n * 16)));
#pragma unroll
                for (int mm = 0; mm < 2; ++mm) { const int m = 2 * mh + mm;
                    float ss = 0.f;
#pragma unroll
                    for (int bj = 0; bj < 2; ++bj)
#pragma unroll
                        for (int n = 0; n < 2; ++n) {
                            const f32x4 h = xl[mm][bj][n] + acc[ai][bj][m][n];
                            ss += (h[0] * h[0] + h[1] * h[1]) + (h[2] * h[2] + h[3] * h[3]);
                            *(f32x4*)(out + (xo0 + (unsigned)((ai * 128 + m * 16) * 1024 + bj * 128 + n * 16))) = h;
                        }
                    ss += __shfl_xor(ss, 16); ss += __shfl_xor(ss, 32);
                    if (fq == 0) atomicAdd(rowss + row0 + ai * 128 + m * 16, ss);
                }
                asm volatile("" ::: "memory");
            }
    }
};

__device__ __forceinline__ int win_dest(int n) {
    if (n < 1152) { const int hh = n >> 6, d = n & 63; return (hh << 6) + 2 * (d & 31) + (d >> 5); }
    if (n < 1280) return n;
    if (n < 2304) return 4608 + (n - 1280);
    if (n < 5504) return 1280 + (n - 2304);
    if (n < 6528) return 5632 + (n - 5504);
    return 6656 + (n - 6528);
}
template <bool MAPPED>
__device__ __forceinline__ void p0_transpose_item(const float* W, int N, bf16_t* WT, LAS float* scr, int item, int lane) {
    const int nblk = N / 32, kb = item / nblk, nb = item % nblk, k0 = 64 * kb, n0 = 32 * nb;
#pragma unroll 8
    for (int i = 0; i < 32; ++i) { const int kk = 2 * i + (lane >> 5); scr[kk * 33 + (lane & 31)] = W[(size_t)(k0 + kk) * N + n0 + (lane & 31)]; }
    asm volatile("s_waitcnt lgkmcnt(0)" ::: "memory");
    const int c = lane & 7;
#pragma unroll
    for (int j = 0; j < 4; ++j) { const int n = (lane >> 3) + 8 * j; const LAS float* s = scr + (8 * c) * 33 + n;
        u32x4 o; o.x = cvt_pk_bf16(s[0 * 33], s[1 * 33]); o.y = cvt_pk_bf16(s[2 * 33], s[3 * 33]); o.z = cvt_pk_bf16(s[4 * 33], s[5 * 33]); o.w = cvt_pk_bf16(s[6 * 33], s[7 * 33]);
        const int dr = MAPPED ? win_dest(n0 + n) : n0 + n;
        *(u32x4*)(WT + (size_t)dr * 1024 + k0 + 8 * c) = o; }
    asm volatile("s_waitcnt lgkmcnt(0)" ::: "memory");
}
__device__ __forceinline__ void rms_row_to_bf16(const float* xrow, const float* nw, bf16_t* orow, int lane) {
    const f32x4* xr = (const f32x4*)xrow + lane; const f32x4* wr4 = (const f32x4*)nw + lane;
    f32x4 v[4]; float s = 0.f;
#pragma unroll
    for (int j = 0; j < 4; ++j) { v[j] = xr[64 * j]; s += (v[j][0] * v[j][0] + v[j][1] * v[j][1]) + (v[j][2] * v[j][2] + v[j][3] * v[j][3]); }
    const float rstd = 1.f / sqrtf(wave_sum(s) * (1.f / DM) + RMS_EPS);
    u32x2* o8 = (u32x2*)orow + lane;
#pragma unroll
    for (int j = 0; j < 4; ++j) { const f32x4 w = wr4[64 * j]; u32x2 o; o.x = cvt_pk_bf16(v[j][0] * rstd * w[0], v[j][1] * rstd * w[1]); o.y = cvt_pk_bf16(v[j][2] * rstd * w[2], v[j][3] * rstd * w[3]); o8[64 * j] = o; }
}
__device__ __forceinline__ void p0_prologue(const Params& P, LAS unsigned char* lds, int G) {
    const int tid = threadIdx.x, lane = tid & 63, wave = tid >> 6;
    LAS float* scr = (LAS float*)(lds + wave * 16384);
    const int gw = blockIdx.x * 8 + wave, NGW = G * 8;
    bf16_t* WinT = (bf16_t*)(P.ws + WS_WIN); bf16_t* WbT = (bf16_t*)(P.ws + WS_WB); bf16_t* WoT = (bf16_t*)(P.ws + WS_WOUT);
    constexpr int I_IN = 16 * (NIN_SRC / 32), I_SQ = 16 * 32;
    for (int it = gw; it < I_IN + 3 * I_SQ; it += NGW) {
        int r = it;
        if (r < I_IN) { p0_transpose_item<true>(P.w_in, NIN_SRC, WinT, scr, r, lane); continue; } r -= I_IN;
        if (r < I_SQ) { p0_transpose_item<false>(P.w_ba, 1024, WbT, scr, r, lane); continue; } r -= I_SQ;
        if (r < I_SQ) { p0_transpose_item<false>(P.w_br, 1024, WbT + (size_t)1024 * 1024, scr, r, lane); continue; } r -= I_SQ;
        p0_transpose_item<false>(P.w_out, 1024, WoT, scr, r, lane);
    }
    for (int i = blockIdx.x * 512 + tid; i < 16384; i += G * 512) *((u32x4*)(WinT + (size_t)4480 * 1024) + i) = (u32x4){0u, 0u, 0u, 0u};
    bf16_t* U = (bf16_t*)(P.ws + WS_U);
    for (int m = gw; m < MREAL + NMETA; m += NGW) {
        const float* src = m < MREAL ? P.x + (size_t)m * DM : P.meta + (size_t)(m - MREAL) * DM;
        rms_row_to_bf16(src, P.norm_w, U + (size_t)m * DM, lane);
    }
    float* rope = (float*)(P.ws + WS_ROPE);
    for (int i = blockIdx.x * 512 + tid; i < TT * 32; i += G * 512) {
        const int pos = i >> 5, k = i & 31;
        const double inv = exp(-9.210340371976184 * (double)k / 32.0);
        const double ang = (double)pos * inv;
        rope[pos * 64 + k] = (float)cos(ang); rope[pos * 64 + 32 + k] = (float)sin(ang);
    }
}

constexpr int KS_STRIDE = 144;
constexpr int VT_STRIDE = 520;
constexpr int ATT_KS = 0, ATT_VT = 256 * KS_STRIDE;
__device__ __forceinline__ int crow(int r, int hi) { return (r & 3) + 8 * (r >> 2) + 4 * hi; }
__device__ __forceinline__ void attn_unit(const Params& P, LAS unsigned char* lds, int unit) {
    int tid_ = threadIdx.x; asm volatile("" : "+v"(tid_));
    const int tid = tid_, lane = tid & 63, wid = tid >> 6, qc = lane & 31, hi = lane >> 5;
    const int g = unit & 1, qb = (unit >> 1) & 63, b = unit >> 7;
    bf16_t* Q = (bf16_t*)(P.ws + WS_Q); const bf16_t* KV = (const bf16_t*)(P.ws + WS_KV);
    const int rb = b * SEQ + qb * 128;
    __syncthreads();
#pragma unroll
    for (int i = 0; i < 4; ++i) {
        const int id = tid + 512 * i, c = id >> 3, ch = id & 7;
        int row; bool ok = true;
        if (c >= 128) row = rb + c - 128; else if (qb > 0) row = rb - 128 + c; else { ok = c >= 112; row = MREAL + c - 112; }
        u32x4 kq = (u32x4){0u, 0u, 0u, 0u}, vq = kq;
        if (ok) { kq = *(const u32x4*)(KV + (size_t)row * 256 + g * 64 + ch * 8); vq = *(const u32x4*)(KV + (size_t)row * 256 + 128 + g * 64 + ch * 8); }
        *(LAS u32x4*)(lds + ATT_KS + c * KS_STRIDE + ch * 16) = kq;
        LAS unsigned short* vt = (LAS unsigned short*)(lds + ATT_VT) + (ch * 8) * (VT_STRIDE / 2) + c;
        vt[0 * (VT_STRIDE / 2)] = (unsigned short)(vq.x & 0xffff); vt[1 * (VT_STRIDE / 2)] = (unsigned short)(vq.x >> 16);
        vt[2 * (VT_STRIDE / 2)] = (unsigned short)(vq.y & 0xffff); vt[3 * (VT_STRIDE / 2)] = (unsigned short)(vq.y >> 16);
        vt[4 * (VT_STRIDE / 2)] = (unsigned short)(vq.z & 0xffff); vt[5 * (VT_STRIDE / 2)] = (unsigned short)(vq.z >> 16);
        vt[6 * (VT_STRIDE / 2)] = (unsigned short)(vq.w & 0xffff); vt[7 * (VT_STRIDE / 2)] = (unsigned short)(vq.w >> 16);
    }
    __syncthreads();
    const int h = g * 8 + wid;
    const float sink2 = P.sinks[h] * LOG2E;
    for (int qt = 0; qt < 4; ++qt) {
        bf16_t* qrow = Q + (size_t)(rb + qt * 32 + qc) * 1024 + h * 64;
        bf16x8 qf[4];
#pragma unroll
        for (int s = 0; s < 4; ++s) qf[s] = *(const bf16x8*)(qrow + s * 16 + hi * 8);
        f32x16 sc[5];
#pragma unroll
        for (int jj = 0; jj < 5; ++jj) {
            sc[jj] = (f32x16){0.f};
            const LAS unsigned char* kp = lds + ATT_KS + (32 * (qt + jj) + qc) * KS_STRIDE + hi * 16;
#pragma unroll
            for (int s = 0; s < 4; ++s) { const bf16x8 kf = *(const LAS bf16x8*)(kp + s * 32); sc[jj] = __builtin_amdgcn_mfma_f32_32x32x16_bf16(kf, qf[s], sc[jj], 0, 0, 0); }
        }
        float mx = sink2;
#pragma unroll
        for (int jj = 0; jj < 5; ++jj)
#pragma unroll
            for (int r = 0; r < 16; ++r) {
                const int kr = crow(r, hi);
                bool ok = true;
                if (jj == 0) ok = kr >= qc + 1;
                if (jj == 4) ok = kr <= qc;
                if (qb == 0) ok = ok && (32 * (qt + jj) + kr >= 112);
                const float v = ok ? sc[jj][r] : -1e30f;
                sc[jj][r] = v; mx = fmaxf(mx, v);
            }
        { auto rr = __builtin_amdgcn_permlane32_swap(__float_as_uint(mx), __float_as_uint(mx), false, false); mx = fmaxf(__uint_as_float(rr[0]), __uint_as_float(rr[1])); }
        float l = 0.f;
#pragma unroll
        for (int jj = 0; jj < 5; ++jj)
#pragma unroll
            for (int r = 0; r < 16; ++r) { const float p = __builtin_amdgcn_exp2f(sc[jj][r] - mx); sc[jj][r] = p; l += p; }
        { auto rr = __builtin_amdgcn_permlane32_swap(__float_as_uint(l), __float_as_uint(l), false, false); l = __uint_as_float(rr[0]) + __uint_as_float(rr[1]); }
        l += __builtin_amdgcn_exp2f(sink2 - mx);
        const float rl = 1.f / l;
        f32x16 o[2]; o[0] = (f32x16){0.f}; o[1] = (f32x16){0.f};
#pragma unroll
        for (int jj = 0; jj < 5; ++jj)
#pragma unroll
            for (int t = 0; t < 2; ++t) {
                u32x4 pw; pw.x = cvt_pk_bf16(sc[jj][8 * t + 0], sc[jj][8 * t + 1]); pw.y = cvt_pk_bf16(sc[jj][8 * t + 2], sc[jj][8 * t + 3]);
                pw.z = cvt_pk_bf16(sc[jj][8 * t + 4], sc[jj][8 * t + 5]); pw.w = cvt_pk_bf16(sc[jj][8 * t + 6], sc[jj][8 * t + 7]);
                const bf16x8 pf = __builtin_bit_cast(bf16x8, pw);
#pragma unroll
                for (int dt = 0; dt < 2; ++dt) {
                    const LAS unsigned char* vp = lds + ATT_VT + (32 * dt + qc) * VT_STRIDE + (32 * (qt + jj) + 16 * t + 4 * hi) * 2;
                    const u32x2 lo = *(const LAS u32x2*)vp, hi2 = *(const LAS u32x2*)(vp + 16);
                    const u32x4 vw = (u32x4){lo.x, lo.y, hi2.x, hi2.y};
                    o[dt] = __builtin_amdgcn_mfma_f32_32x32x16_bf16(__builtin_bit_cast(bf16x8, vw), pf, o[dt], 0, 0, 0);
                }
            }
#pragma unroll
        for (int dt = 0; dt < 2; ++dt)
#pragma unroll
            for (int rq = 0; rq < 4; ++rq) {
                u32x2 w; w.x = cvt_pk_bf16(o[dt][4 * rq + 0] * rl, o[dt][4 * rq + 1] * rl); w.y = cvt_pk_bf16(o[dt][4 * rq + 2] * rl, o[dt][4 * rq + 3] * rl);
                *(u32x2*)(qrow + 32 * dt + 8 * rq + 4 * hi) = w;
            }
    }
}

constexpr int TC = 32;
constexpr int SC_W2 = 0, SC_A2 = 16384, SC_TW = 32768, SC_ZAL = 40960, SC_R = 49152, SC_W = 57344, SC_K = 65536, SC_A = 73728, SC_B = 81920, SC_V = 90112, SC_Y = 98304, SC_BON = 106496;
__device__ __forceinline__ void scan_item(const Params& P, LAS unsigned char* lds, int item) {
    const int tid = threadIdx.x, lane = tid & 63, wid = tid >> 6;
    const int b = item >> 4, h = item & 15, hj = h * 64 + lane;
    const bf16_t* RKV = (const bf16_t*)(P.ws + WS_RKV); const bf16_t* WA = (const bf16_t*)(P.ws + WS_WA); bf16_t* RW = (bf16_t*)(P.ws + WS_RW);
    LAS float* w2s = (LAS float*)(lds + SC_W2); LAS float* a2s = (LAS float*)(lds + SC_A2); LAS float* tw = (LAS float*)(lds + SC_TW); LAS float* zal = (LAS float*)(lds + SC_ZAL);
    LAS float* Rs = (LAS float*)(lds + SC_R); LAS float* Ws = (LAS float*)(lds + SC_W); LAS float* Ks = (LAS float*)(lds + SC_K); LAS float* As = (LAS float*)(lds + SC_A);
    LAS float* Bs = (LAS float*)(lds + SC_B); LAS float* Vs = (LAS float*)(lds + SC_V); LAS float* Ys = (LAS float*)(lds + SC_Y); LAS float* BON = (LAS float*)(lds + SC_BON);
    __syncthreads();
    for (int i = tid; i < 4096; i += 512) { const int r = i >> 6, c = i & 63; w2s[i] = P.w2[(size_t)r * 1024 + h * 64 + c]; a2s[i] = P.a2[(size_t)r * 1024 + h * 64 + c]; }
    const float mu_r = P.mu[hj], mu_k = P.mu[1024 + hj], mu_v = P.mu[2048 + hj], mu_wl = P.mu[3072 + lane], mu_al = P.mu[3136 + lane];
    const float w0v = P.w0[hj], a0v = P.a0[hj], kkv = P.k_k[hj], kav = P.k_a[hj], rkv = P.r_k[hj], lnw = P.ln_w[hj], lnb = P.ln_b[hj];
    float S[8];
#pragma unroll
    for (int c = 0; c < 8; ++c) S[c] = 0.f;
    const int srow = tid >> 3, scg = tid & 7;
    for (int t0 = 0; t0 < TT; t0 += TC) {
        const int nt = (TT - t0) < TC ? (TT - t0) : TC;
        float zr[4], zk[4], zv[4];
        {
            float pr = 0.f, pk = 0.f, pv = 0.f, pwl = 0.f, pal = 0.f;
            const int tp = t0 + 4 * wid - 1;
            if (tp >= 0 && tp < TT) { const size_t row = tp < NMETA ? (size_t)MREAL + tp : (size_t)b * SEQ + tp - NMETA;
                pr = bf2f(RKV[row * 3072 + hj]); pk = bf2f(RKV[row * 3072 + 1024 + hj]); pv = bf2f(RKV[row * 3072 + 2048 + hj]); pwl = bf2f(WA[row * 128 + lane]); pal = bf2f(WA[row * 128 + 64 + lane]); }
#pragma unroll
            for (int q = 0; q < 4; ++q) {
                const int tl = 4 * wid + q, tk = t0 + tl;
                float cr = 0.f, ck = 0.f, cv = 0.f, cwl = 0.f, cal = 0.f;
                if (tk < TT) { const size_t row = tk < NMETA ? (size_t)MREAL + tk : (size_t)b * SEQ + tk - NMETA;
                    cr = bf2f(RKV[row * 3072 + hj]); ck = bf2f(RKV[row * 3072 + 1024 + hj]); cv = bf2f(RKV[row * 3072 + 2048 + hj]); cwl = bf2f(WA[row * 128 + lane]); cal = bf2f(WA[row * 128 + 64 + lane]); }
                zr[q] = cr + (pr - cr) * mu_r; zk[q] = ck + (pk - ck) * mu_k; zv[q] = cv + (pv - cv) * mu_v;
                tw[tl * 64 + lane] = tanhf(cwl + (pwl - cwl) * mu_wl); zal[tl * 64 + lane] = cal + (pal - cal) * mu_al;
                pr = cr; pk = ck; pv = cv; pwl = cwl; pal = cal;
            }
        }
        __syncthreads();
        float aw[4], aa[4];
#pragma unroll
        for (int q = 0; q < 4; ++q) { aw[q] = w0v; aa[q] = a0v; }
        for (int i = 0; i < 64; ++i) {
            const float wv = w2s[i * 64 + lane], av = a2s[i * 64 + lane];
#pragma unroll
            for (int q = 0; q < 4; ++q) { aw[q] += tw[(4 * wid + q) * 64 + i] * wv; aa[q] += zal[(4 * wid + q) * 64 + i] * av; }
        }
#pragma unroll
        for (int q = 0; q < 4; ++q) {
            const int tl = 4 * wid + q;
            const float y = -aw[q];
            const float sp = fmaxf(y, 0.f) + log1pf(expf(-fabsf(y)));
            const float wlog = -sp - 0.5f;
            const float decay = expf(-expf(wlog));
            const float a = 1.f / (1.f + expf(-aa[q]));
            float kk = zk[q] * kkv;
            const float n2 = wave_sum(kk * kk);
            kk = kk / fmaxf(sqrtf(n2), 1e-12f);
            const float kp = zk[q] * (1.f + (a - 1.f) * kav);
            const float bon = wave_sum(zr[q] * kp * rkv);
            Rs[tl * 64 + lane] = zr[q]; Ws[tl * 64 + lane] = decay; Ks[tl * 64 + lane] = kp; As[tl * 64 + lane] = -kk; Bs[tl * 64 + lane] = kk * a; Vs[tl * 64 + lane] = zv[q];
            if (lane == 0) BON[tl] = bon;
        }
        __syncthreads();
        for (int t = 0; t < nt; ++t) {
            const f32x4 w_0 = *(const LAS f32x4*)(Ws + t * 64 + 8 * scg), w_1 = *(const LAS f32x4*)(Ws + t * 64 + 8 * scg + 4);
            const f32x4 a_0 = *(const LAS f32x4*)(As + t * 64 + 8 * scg), a_1 = *(const LAS f32x4*)(As + t * 64 + 8 * scg + 4);
            const f32x4 b_0 = *(const LAS f32x4*)(Bs + t * 64 + 8 * scg), b_1 = *(const LAS f32x4*)(Bs + t * 64 + 8 * scg + 4);
            const f32x4 k_0 = *(const LAS f32x4*)(Ks + t * 64 + 8 * scg), k_1 = *(const LAS f32x4*)(Ks + t * 64 + 8 * scg + 4);
            const f32x4 r_0 = *(const LAS f32x4*)(Rs + t * 64 + 8 * scg), r_1 = *(const LAS f32x4*)(Rs + t * 64 + 8 * scg + 4);
            const float v = Vs[t * 64 + srow];
            float sa = (S[0] * a_0[0] + S[1] * a_0[1]) + (S[2] * a_0[2] + S[3] * a_0[3]) + (S[4] * a_1[0] + S[5] * a_1[1]) + (S[6] * a_1[2] + S[7] * a_1[3]);
            sa = red8(sa);
#pragma unroll
            for (int c = 0; c < 4; ++c) { S[c] = S[c] * w_0[c] + sa * b_0[c] + v * k_0[c]; S[4 + c] = S[4 + c] * w_1[c] + sa * b_1[c] + v * k_1[c]; }
            float y = (S[0] * r_0[0] + S[1] * r_0[1]) + (S[2] * r_0[2] + S[3] * r_0[3]) + (S[4] * r_1[0] + S[5] * r_1[1]) + (S[6] * r_1[2] + S[7] * r_1[3]);
            y = red8(y);
            if (scg == 0) Ys[t * 64 + srow] = y;
        }
        __syncthreads();
#pragma unroll
        for (int q = 0; q < 4; ++q) {
            const int tl = 4 * wid + q, tk = t0 + tl;
            const float y = Ys[tl * 64 + lane];
            const float mean = wave_sum(y) * (1.f / 64.f);
            const float d = y - mean;
            const float var = wave_sum(d * d) * (1.f / 64.f);
            const float o = d * (1.f / sqrtf(var + GN_EPS)) * lnw + lnb + BON[tl] * Vs[tl * 64 + lane];
            if (tl < nt && tk >= NMETA) RW[((size_t)b * SEQ + tk - NMETA) * 1024 + hj] = f2bf(o);
        }
        __syncthreads();
    }
}

constexpr int CH = 16, NCHUNK = TT / CH;
constexpr int IMG_STRIDE = 144;
constexpr int SL_IMG_A = 0, SL_IMG_R = 2304, SL_IMG_B = 4608, SL_IMG_K = 6912, SL_IMG_V = 9216, SL_NAK = 11520, SL_TT = 12032, SL_MT = 12544, SL_GAM = 13568, SL_BON = 13824, SLOT_BYTES = 13888;
constexpr int SCR_STRIDE = 272;
constexpr int SL_SCR_W = 0, SL_SCR_A = 16 * SCR_STRIDE;
constexpr int NSLOT = 9;
constexpr int FL_FULL = 0, FL_CDONE = 48, FL_YDONE = 56;
constexpr int CS_W2IMG = NSLOT * SLOT_BYTES, CS_A2IMG = CS_W2IMG + 8192, CS_CONST = CS_A2IMG + 8192, CS_FLAGS = CS_CONST + 12 * 256, CS_YRING = CS_FLAGS + 64, YENT_BYTES = 16 * IMG_STRIDE, CS_END = CS_YRING + 8 * YENT_BYTES;
static_assert(CS_END <= LDS_BARST, "scan LDS map");
enum { CK_MU_R = 0, CK_MU_K, CK_MU_V, CK_MU_WL, CK_MU_AL, CK_W0, CK_A0, CK_KK, CK_KA, CK_RK, CK_LNW, CK_LNB };
typedef short v4i16 __attribute__((ext_vector_type(4)));
__device__ __forceinline__ u32x2 lds_tr16(const LAS unsigned char* p) { return __builtin_bit_cast(u32x2, __builtin_amdgcn_ds_read_tr16_b64_v4i16((LAS v4i16*)p)); }
__device__ __forceinline__ void lds_wait_ge(LAS unsigned char* p, int v) { while (*(volatile LAS int*)p < v) __builtin_amdgcn_s_sleep(1); asm volatile("" ::: "memory"); }
__device__ __forceinline__ void lds_flag_set(LAS unsigned char* p, int v, int lane) { asm volatile("s_waitcnt lgkmcnt(0)" ::: "memory"); if (lane == 0) *(volatile LAS int*)p = v; asm volatile("" ::: "memory"); }
__device__ __forceinline__ bf16x8 mk_frag(u32x2 lo, u32x2 hi) { return __builtin_bit_cast(bf16x8, (u32x4){lo.x, lo.y, hi.x, hi.y}); }
__device__ __forceinline__ u32x2 pk4(f32x4 v) { return (u32x2){cvt_pk_bf16(v[0], v[1]), cvt_pk_bf16(v[2], v[3])}; }
__device__ __forceinline__ void unpack8(u32x4 w, float* f) { f[0] = bflo(w.x); f[1] = bfhi(w.x); f[2] = bflo(w.y); f[3] = bfhi(w.y); f[4] = bflo(w.z); f[5] = bfhi(w.z); f[6] = bflo(w.w); f[7] = bfhi(w.w); }
__device__ __forceinline__ u32x4 pack8(const float* f) { return (u32x4){cvt_pk_bf16(f[0], f[1]), cvt_pk_bf16(f[2], f[3]), cvt_pk_bf16(f[4], f[5]), cvt_pk_bf16(f[6], f[7])}; }
__device__ __forceinline__ float red16(float v) {
    v += dppf<0xB1>(v); v += dppf<0x4E>(v); v += dppf<0x141>(v); v += dppf<0x140>(v); return v;
}
__device__ __forceinline__ float scan16(float v) {
    v += dppf<0x111>(v); v += dppf<0x112>(v); v += dppf<0x114>(v); v += dppf<0x118>(v); return v;
}
__device__ __forceinline__ float shr1_fill1(float v) {
    return __builtin_bit_cast(float, __builtin_amdgcn_update_dpp(0x3f800000, __builtin_bit_cast(int, v), 0x111, 0xF, 0xF, false));
}
#define MFMA32(a, b, c) __builtin_amdgcn_mfma_f32_16x16x32_bf16((a), (b), (c), 0, 0, 0)

__device__ __forceinline__ size_t scan_row(int b, int tau) { return tau < NMETA ? (size_t)MREAL + tau : (size_t)b * SEQ + (tau - NMETA); }

__device__ __forceinline__ void unpack4(u32x2 w, float* f) { f[0] = bflo(w.x); f[1] = bfhi(w.x); f[2] = bflo(w.y); f[3] = bfhi(w.y); }
__device__ __forceinline__ u32x2 pack4(const float* f) { return (u32x2){cvt_pk_bf16(f[0], f[1]), cvt_pk_bf16(f[2], f[3])}; }
__device__ __forceinline__ unsigned long long scan_producer(const Params& P, LAS unsigned char* lds, int b, int h, int pidx, int lane) {
    unsigned long long pticks = 0ull;
    const int t = lane & 15, g = lane >> 4;
    const bf16_t* RKV = (const bf16_t*)(P.ws + WS_RKV); const bf16_t* WA = (const bf16_t*)(P.ws + WS_WA);
    bf16_t* RW = (bf16_t*)(P.ws + WS_RW);
    const LAS unsigned char* cstg = lds + CS_CONST + 16 * g;
#define CROW(k, jt) (*(const LAS f32x4*)(cstg + ((k) * 256 + 64 * (jt))))
    const f32x4 fzero = (f32x4){0.f, 0.f, 0.f, 0.f};
    u32x2 raw_wa[2][2][4];
#define ISSUE_WA(cc) do { const int tau_ = 16 * (cc) + t; const size_t rc_ = scan_row(b, tau_), rp_ = scan_row(b, tau_ > 0 ? tau_ - 1 : 0); \
        _Pragma("unroll") for (int a_ = 0; a_ < 2; ++a_) _Pragma("unroll") for (int j_ = 0; j_ < 4; ++j_) { \
            raw_wa[a_][0][j_] = *(const u32x2*)(WA + rc_ * 128 + a_ * 64 + 16 * j_ + 4 * g); raw_wa[a_][1][j_] = *(const u32x2*)(WA + rp_ * 128 + a_ * 64 + 16 * j_ + 4 * g); } } while (0)
    u32x2 vprev[4] = {(u32x2){0u, 0u}, (u32x2){0u, 0u}, (u32x2){0u, 0u}, (u32x2){0u, 0u}}; float bon_prev = 0.f;
#define FINISH(cp) do { if ((cp) >= 1) { \
        unsigned long long fw0_ = 0ull; if (PROBE_PHASE == 28 || PROBE_PHASE == 29) fw0_ = __builtin_amdgcn_s_memrealtime(); \
        lds_wait_ge(lds + CS_FLAGS + FL_YDONE, (cp) + 1); lds_wait_ge(lds + CS_FLAGS + FL_YDONE + 4, (cp) + 1); \
        if (PROBE_PHASE == 28) pticks += __builtin_amdgcn_s_memrealtime() - fw0_; \
        const LAS unsigned char* yb_ = lds + CS_YRING + ((cp) & 7) * YENT_BYTES + t * IMG_STRIDE + 8 * g; \
        float y_[16], v_[16]; _Pragma("unroll") for (int j_ = 0; j_ < 4; ++j_) { unpack4(*(const LAS u32x2*)(yb_ + 32 * j_), y_ + 4 * j_); unpack4(vprev[j_], v_ + 4 * j_); } \
        float s1_ = 0.f; _Pragma("unroll") for (int i_ = 0; i_ < 16; ++i_) s1_ += y_[i_]; \
        s1_ += __shfl_xor(s1_, 16); s1_ += __shfl_xor(s1_, 32); const float mean_ = s1_ * (1.f / 64.f); \
        float s2_ = 0.f; _Pragma("unroll") for (int i_ = 0; i_ < 16; ++i_) { y_[i_] -= mean_; s2_ += y_[i_] * y_[i_]; } \
        s2_ += __shfl_xor(s2_, 16); s2_ += __shfl_xor(s2_, 32); const float rstd_ = __builtin_amdgcn_rsqf(s2_ * (1.f / 64.f) + GN_EPS); \
        bf16_t* orow_ = RW + ((size_t)b * SEQ + 16 * ((cp) - 1) + t) * 1024 + h * 64 + 4 * g; \
        _Pragma("unroll") for (int j_ = 0; j_ < 4; ++j_) { float o_[4]; const f32x4 w_ = CROW(CK_LNW, j_), b_ = CROW(CK_LNB, j_); \
            _Pragma("unroll") for (int e_ = 0; e_ < 4; ++e_) o_[e_] = y_[4 * j_ + e_] * rstd_ * w_[e_] + b_[e_] + bon_prev * v_[4 * j_ + e_]; \
            *(u32x2*)(orow_ + 16 * j_) = pack4(o_); } \
        if (PROBE_PHASE == 29) pticks += __builtin_amdgcn_s_memrealtime() - fw0_; } } while (0)
    ISSUE_WA(pidx);
    for (int k_ = 0; k_ < 2 * pidx; ++k_) __builtin_amdgcn_s_sleep(17);
    int clast = -1;
    unsigned long long sgt_ = 0ull;
#define SEG_START() do { if (PROBE_PHASE >= 23 && PROBE_PHASE < 28) sgt_ = __builtin_amdgcn_s_memrealtime(); } while (0)
#define SEG_END(k) do { if (PROBE_PHASE >= 23 && PROBE_PHASE < 28) { const unsigned long long n_ = __builtin_amdgcn_s_memrealtime(); if (PROBE_PHASE == (k)) pticks += n_ - sgt_; sgt_ = n_; } } while (0)
    for (int c = pidx; c < NCHUNK; c += 6) {
        LAS unsigned char* slot = lds + (c % NSLOT) * SLOT_BYTES;
        SEG_START();
        u32x2 raw_rkv[3][2][4];
        { const int tau_ = 16 * c + t; const size_t rc_ = scan_row(b, tau_), rp_ = scan_row(b, tau_ > 0 ? tau_ - 1 : 0);
#pragma unroll
          for (int a_ = 0; a_ < 3; ++a_)
#pragma unroll
            for (int j_ = 0; j_ < 4; ++j_) { raw_rkv[a_][0][j_] = *(const u32x2*)(RKV + rc_ * 3072 + a_ * 1024 + h * 64 + 16 * j_ + 4 * g); raw_rkv[a_][1][j_] = *(const u32x2*)(RKV + rp_ * 3072 + a_ * 1024 + h * 64 + 16 * j_ + 4 * g); } }
        if (c == 0 && t == 0) {
            const u32x2 zz2 = (u32x2){0u, 0u};
#pragma unroll
            for (int j_ = 0; j_ < 4; ++j_) { raw_rkv[0][1][j_] = zz2; raw_rkv[1][1][j_] = zz2; raw_rkv[2][1][j_] = zz2; raw_wa[0][1][j_] = zz2; raw_wa[1][1][j_] = zz2; }
        }
        bf16x8 twf[2], alf[2];
        { float tw[16], al[16];
#pragma unroll
          for (int j = 0; j < 4; ++j) { float cu[4], pr[4];
            const f32x4 m = CROW(CK_MU_WL, j), n = CROW(CK_MU_AL, j);
            unpack4(raw_wa[0][0][j], cu); unpack4(raw_wa[0][1][j], pr);
#pragma unroll
            for (int e = 0; e < 4; ++e) { const float zz = cu[e] + (pr[e] - cu[e]) * m[e]; const float ex = __builtin_amdgcn_exp2f(zz * (2.f * LOG2E)); tw[4 * j + e] = 1.f - 2.f * __builtin_amdgcn_rcpf(1.f + ex); }
            unpack4(raw_wa[1][0][j], cu); unpack4(raw_wa[1][1][j], pr);
#pragma unroll
            for (int e = 0; e < 4; ++e) al[4 * j + e] = cu[e] + (pr[e] - cu[e]) * n[e]; }
#pragma unroll
          for (int s = 0; s < 2; ++s) { twf[s] = __builtin_bit_cast(bf16x8, pack8(tw + 8 * s)); alf[s] = __builtin_bit_cast(bf16x8, pack8(al + 8 * s)); } }
        if (c + 6 < NCHUNK) ISSUE_WA(c + 6);
        float wr[16], ar[16];
#pragma unroll
        for (int j = 0; j < 4; ++j) { f32x4 aw = fzero, aa = fzero;
#pragma unroll
            for (int s = 0; s < 2; ++s) {
                aw = MFMA32(*(const LAS bf16x8*)(lds + CS_W2IMG + ((s * 4 + j) * 64 + lane) * 16), twf[s], aw);
                aa = MFMA32(*(const LAS bf16x8*)(lds + CS_A2IMG + ((s * 4 + j) * 64 + lane) * 16), alf[s], aa);
            }
#pragma unroll
            for (int r = 0; r < 4; ++r) { wr[4 * j + r] = aw[r]; ar[4 * j + r] = aa[r]; } }
        SEG_END(23);
        __builtin_amdgcn_sched_barrier(0);
        float zr[16], zk[16];
#pragma unroll
        for (int j = 0; j < 4; ++j) { float cu[4], pr[4];
            const f32x4 mr_ = CROW(CK_MU_R, j), mk_ = CROW(CK_MU_K, j);
            unpack4(raw_rkv[0][0][j], cu); unpack4(raw_rkv[0][1][j], pr);
#pragma unroll
            for (int e = 0; e < 4; ++e) zr[4 * j + e] = cu[e] + (pr[e] - cu[e]) * mr_[e];
            unpack4(raw_rkv[1][0][j], cu); unpack4(raw_rkv[1][1][j], pr);
#pragma unroll
            for (int e = 0; e < 4; ++e) zk[4 * j + e] = cu[e] + (pr[e] - cu[e]) * mk_[e]; }
        SEG_END(25);
        __builtin_amdgcn_sched_barrier(0);
        float ss = 0.f, bon = 0.f; float av[16];
#pragma unroll
        for (int j = 0; j < 4; ++j) {
            const f32x4 c_a0 = CROW(CK_A0, j), c_kk = CROW(CK_KK, j), c_ka = CROW(CK_KA, j), c_rk = CROW(CK_RK, j);
#pragma unroll
            for (int e = 0; e < 4; ++e) { const int i = 4 * j + e;
                const float a = sigmoidf_(c_a0[e] + ar[i]); av[i] = a;
                const float kr_ = zk[i] * c_kk[e]; ss += kr_ * kr_;
                bon += zr[i] * (zk[i] * (1.f + (a - 1.f) * c_ka[e])) * c_rk[e]; }
        }
        ss += __shfl_xor(ss, 16); ss += __shfl_xor(ss, 32); bon += __shfl_xor(bon, 16); bon += __shfl_xor(bon, 32);
        const float inv = 1.f / fmaxf(sqrtf(ss), 1e-12f);
        __builtin_amdgcn_sched_barrier(0);
        { unsigned long long pt0_ = 0ull; if (PROBE_PHASE == 22) pt0_ = __builtin_amdgcn_s_memrealtime();
          if (c >= NSLOT) { lds_wait_ge(lds + CS_FLAGS + FL_CDONE, c - NSLOT + 1); lds_wait_ge(lds + CS_FLAGS + FL_CDONE + 4, c - NSLOT + 1); }
          if (PROBE_PHASE == 22) pticks += __builtin_amdgcn_s_memrealtime() - pt0_; }
        u32x2 vnew[4];
#pragma unroll
        for (int j = 0; j < 4; ++j) { float cu[4], pr[4], z[4]; const f32x4 mv_ = CROW(CK_MU_V, j);
            unpack4(raw_rkv[2][0][j], cu); unpack4(raw_rkv[2][1][j], pr);
#pragma unroll
            for (int e = 0; e < 4; ++e) z[e] = cu[e] + (pr[e] - cu[e]) * mv_[e];
            vnew[j] = pack4(z); *(LAS u32x2*)(slot + SL_IMG_V + t * IMG_STRIDE + (16 * j + 4 * g) * 2) = vnew[j]; }
        if (g == 0) *(LAS float*)(slot + SL_BON + t * 4) = bon;
        __builtin_amdgcn_sched_barrier(0);
        u32x4 pA[2], pR[2], pB[2], pK[2];
#pragma unroll
        for (int s = 0; s < 2; ++s) {
            float fa[8], fr_[8], fb[8], fk[8];
#pragma unroll
            for (int q = 0; q < 2; ++q) {
                const int j = 2 * s + q; float gm_[4];
                const f32x4 c_w0 = CROW(CK_W0, j), c_kk = CROW(CK_KK, j), c_ka = CROW(CK_KA, j);
#pragma unroll
                for (int e = 0; e < 4; ++e) { const int i = 4 * j + e, k = 4 * q + e;
                    const float lw = -0.6065306597126334f * sigmoidf_(c_w0[e] + wr[i]);
                    const float L = scan16(lw);
                    const float eL = __builtin_amdgcn_exp2f(L * LOG2E), ieL = __builtin_amdgcn_rcpf(eL), eLm = shr1_fill1(eL);
                    const float kk = zk[i] * c_kk[e] * inv, kp = zk[i] * (1.f + (av[i] - 1.f) * c_ka[e]);
                    fa[k] = -kk * eLm; fb[k] = kk * av[i] * ieL; fk[k] = kp * ieL; fr_[k] = zr[i] * eL; gm_[e] = eL; }
                if (t == 15) *(LAS f32x4*)(slot + SL_GAM + (16 * j + 4 * g) * 4) = (f32x4){gm_[0], gm_[1], gm_[2], gm_[3]};
            }
            pA[s] = pack8(fa); pR[s] = pack8(fr_); pB[s] = pack8(fb); pK[s] = pack8(fk);
#pragma unroll
            for (int q = 0; q < 2; ++q) { const int off = t * IMG_STRIDE + (16 * (2 * s + q) + 4 * g) * 2;
                *(LAS u32x2*)(slot + SL_IMG_A + off) = q ? (u32x2){pA[s].z, pA[s].w} : (u32x2){pA[s].x, pA[s].y};
                *(LAS u32x2*)(slot + SL_IMG_R + off) = q ? (u32x2){pR[s].z, pR[s].w} : (u32x2){pR[s].x, pR[s].y};
                *(LAS u32x2*)(slot + SL_IMG_B + off) = q ? (u32x2){pB[s].z, pB[s].w} : (u32x2){pB[s].x, pB[s].y};
                *(LAS u32x2*)(slot + SL_IMG_K + off) = q ? (u32x2){pK[s].z, pK[s].w} : (u32x2){pK[s].x, pK[s].y}; }
            __builtin_amdgcn_sched_barrier(0);
        }
        SEG_END(26);
        bf16x8 Af[2], Rf[2], Bf[2], Kf[2];
#pragma unroll
        for (int s = 0; s < 2; ++s) { Af[s] = __builtin_bit_cast(bf16x8, pA[s]); Rf[s] = __builtin_bit_cast(bf16x8, pR[s]); Bf[s] = __builtin_bit_cast(bf16x8, pB[s]); Kf[s] = __builtin_bit_cast(bf16x8, pK[s]); }
        f32x4 nab = MFMA32(Bf[0], Af[0], fzero), nabT = MFMA32(Af[0], Bf[0], fzero), nak = MFMA32(Kf[0], Af[0], fzero), mbr = MFMA32(Bf[0], Rf[0], fzero), mkr = MFMA32(Kf[0], Rf[0], fzero);
        nab = MFMA32(Bf[1], Af[1], nab); nabT = MFMA32(Af[1], Bf[1], nabT); nak = MFMA32(Kf[1], Af[1], nak); mbr = MFMA32(Bf[1], Rf[1], mbr); mkr = MFMA32(Kf[1], Rf[1], mkr);
#pragma unroll
        for (int r = 0; r < 4; ++r) { const int s_ = 4 * g + r;
            if (!(s_ < t)) { nab[r] = 0.f; nak[r] = 0.f; }
            if (!(s_ <= t)) { mbr[r] = 0.f; mkr[r] = 0.f; }
            if (!(t < s_)) nabT[r] = 0.f; }
        const u32x2 z2 = (u32x2){0u, 0u};
#define FRG(x) mk_frag(pk4(x), z2)
        const bf16x8 fN = FRG(nab), fNT = FRG(nabT);
        const f32x4 n2 = MFMA32(fNT, fN, fzero), n2T = MFMA32(fN, fNT, fzero);
        const bf16x8 fN2 = FRG(n2), fN2T = FRG(n2T);
        const f32x4 n4 = MFMA32(fN2T, fN2, fzero), n4T = MFMA32(fN2, fN2T, fzero);
        const bf16x8 fN4 = FRG(n4), fN4T = FRG(n4T);
        const f32x4 n8T = MFMA32(fN4, fN4T, fzero);
        f32x4 q0 = nab;
#pragma unroll
        for (int r = 0; r < 4; ++r) if (4 * g + r == t) q0[r] += 1.f;
        const f32x4 q1 = MFMA32(fN2T, FRG(q0), q0);
        const f32x4 q2 = MFMA32(fN4T, FRG(q1), q1);
        const f32x4 tt = MFMA32(FRG(n8T), FRG(q2), q2);
#undef FRG
        *(LAS u32x2*)(slot + SL_NAK + lane * 8) = pk4(nak);
        *(LAS u32x2*)(slot + SL_TT + lane * 8) = pk4(tt);
        { const u32x2 a = pk4(mbr), bq = pk4(mkr); *(LAS u32x4*)(slot + SL_MT + lane * 16) = (u32x4){a.x, a.y, bq.x, bq.y}; }
        SEG_END(27);
        FINISH(clast);
#pragma unroll
        for (int j = 0; j < 4; ++j) vprev[j] = vnew[j];
        bon_prev = bon; clast = c;
        lds_flag_set(lds + CS_FLAGS + FL_FULL + 4 * (c % NSLOT), c + 1, lane);
        SEG_END(24);
    }
    FINISH(clast);
#undef FINISH
#undef ISSUE_WA
#undef CROW
#undef SEG_START
#undef SEG_END
    return pticks;
}

__device__ __forceinline__ unsigned long long scan_consumer(const Params& P, LAS unsigned char* lds, int b, int h, int wc, int lane) {
    unsigned long long pticks = 0ull;
#define PTICK_BEGIN(k) unsigned long long pt0_ = 0ull; if (PROBE_PHASE == (k)) pt0_ = __builtin_amdgcn_s_memrealtime()
#define PTICK_END(k) if (PROBE_PHASE == (k)) pticks += __builtin_amdgcn_s_memrealtime() - pt0_
    const int i16 = lane & 15, g = lane >> 4;
    const f32x4 fzero = (f32x4){0.f, 0.f, 0.f, 0.f};
    const u32x2 z2 = (u32x2){0u, 0u};
    f32x4 sacc[2][4];
#pragma unroll
    for (int n = 0; n < 2; ++n)
#pragma unroll
        for (int j = 0; j < 4; ++j) sacc[n][j] = fzero;
    __builtin_amdgcn_s_setprio(3);
    for (int c = 0; c < NCHUNK; ++c) {
        LAS unsigned char* slot = lds + (c % NSLOT) * SLOT_BYTES;
        { PTICK_BEGIN(20); lds_wait_ge(lds + CS_FLAGS + FL_FULL + 4 * (c % NSLOT), c + 1); PTICK_END(20); }
        bf16x8 Af[2], Rf[2];
#pragma unroll
        for (int s = 0; s < 2; ++s) {
            const int off = i16 * IMG_STRIDE + (32 * s + 4 * g) * 2;
            Af[s] = mk_frag(*(const LAS u32x2*)(slot + SL_IMG_A + off), *(const LAS u32x2*)(slot + SL_IMG_A + off + 32));
            Rf[s] = mk_frag(*(const LAS u32x2*)(slot + SL_IMG_R + off), *(const LAS u32x2*)(slot + SL_IMG_R + off + 32));
        }
        const u32x2 nak = *(const LAS u32x2*)(slot + SL_NAK + lane * 8), ttf = *(const LAS u32x2*)(slot + SL_TT + lane * 8);
        const bf16x8 MTf = *(const LAS bf16x8*)(slot + SL_MT + lane * 16);
        const int troff = (4 * g + (i16 >> 2)) * IMG_STRIDE + (i16 & 3) * 8;
        bf16x8 BKf[4];
#pragma unroll
        for (int jt = 0; jt < 4; ++jt) BKf[jt] = mk_frag(lds_tr16(slot + SL_IMG_B + troff + jt * 32), lds_tr16(slot + SL_IMG_K + troff + jt * 32));
        u32x2 vt[2];
#pragma unroll
        for (int n = 0; n < 2; ++n) vt[n] = lds_tr16(slot + SL_IMG_V + troff + (2 * wc + n) * 32);
        f32x4 gm[4];
#pragma unroll
        for (int jt = 0; jt < 4; ++jt) gm[jt] = *(const LAS f32x4*)(slot + SL_GAM + (16 * jt + 4 * g) * 4);
        lds_flag_set(lds + CS_FLAGS + FL_CDONE + 4 * wc, c + 1, lane);
        f32x4 yacc[2]; bf16x8 S0[2], S1[2], UV[2]; f32x4 x[2], u[2];
#pragma unroll
        for (int n = 0; n < 2; ++n) { S0[n] = mk_frag(pk4(sacc[n][0]), pk4(sacc[n][1])); S1[n] = mk_frag(pk4(sacc[n][2]), pk4(sacc[n][3])); }
#pragma unroll
        for (int n = 0; n < 2; ++n) x[n] = MFMA32(Af[0], S0[n], fzero);
#pragma unroll
        for (int n = 0; n < 2; ++n) x[n] = MFMA32(Af[1], S1[n], x[n]);
#pragma unroll
        for (int n = 0; n < 2; ++n) x[n] = MFMA32(mk_frag(z2, nak), mk_frag(z2, vt[n]), x[n]);
#pragma unroll
        for (int n = 0; n < 2; ++n) yacc[n] = MFMA32(Rf[0], S0[n], fzero);
#pragma unroll
        for (int n = 0; n < 2; ++n) yacc[n] = MFMA32(Rf[1], S1[n], yacc[n]);
#pragma unroll
        for (int n = 0; n < 2; ++n) u[n] = MFMA32(mk_frag(ttf, z2), mk_frag(pk4(x[n]), z2), fzero);
#pragma unroll
        for (int n = 0; n < 2; ++n) UV[n] = mk_frag(pk4(u[n]), vt[n]);
#pragma unroll
        for (int jt = 0; jt < 4; ++jt)
#pragma unroll
            for (int n = 0; n < 2; ++n) { const f32x4 sn = MFMA32(BKf[jt], UV[n], sacc[n][jt]); sacc[n][jt] = sn * gm[jt]; }
#pragma unroll
        for (int n = 0; n < 2; ++n) yacc[n] = MFMA32(MTf, UV[n], yacc[n]);
        { LAS unsigned char* yb = lds + CS_YRING + (c & 7) * YENT_BYTES;
#pragma unroll
          for (int n = 0; n < 2; ++n)
#pragma unroll
            for (int r = 0; r < 4; ++r) *(LAS unsigned short*)(yb + (4 * g + r) * IMG_STRIDE + (16 * (2 * wc + n) + i16) * 2) = f2bf(yacc[n][r]); }
        lds_flag_set(lds + CS_FLAGS + FL_YDONE + 4 * wc, c + 1, lane);
    }
    __builtin_amdgcn_s_setprio(0);
    return pticks;
#undef PTICK_BEGIN
#undef PTICK_END
}

__device__ __forceinline__ unsigned long long scan_item_chunked(const Params& P, LAS unsigned char* lds, int item) {
    int tid_ = threadIdx.x; asm volatile("" : "+v"(tid_));
    const int tid = tid_, lane = tid & 63, wid = __builtin_amdgcn_readfirstlane(tid >> 6);
    const int b = item >> 4, h = item & 15;
    __syncthreads();
    {
        const int fs = tid >> 8, fjt = (tid >> 6) & 3, l = tid & 63;
        float f[8], f2[8];
#pragma unroll
        for (int e = 0; e < 8; ++e) { const size_t idx = (size_t)(32 * fs + 16 * (e >> 2) + 4 * (l >> 4) + (e & 3)) * 1024 + h * 64 + 16 * fjt + (l & 15); f[e] = P.w2[idx]; f2[e] = P.a2[idx]; }
        *(LAS u32x4*)(lds + CS_W2IMG + tid * 16) = pack8(f); *(LAS u32x4*)(lds + CS_A2IMG + tid * 16) = pack8(f2);
    }
    if (tid < 64) {
        LAS float* cf = (LAS float*)(lds + CS_CONST); const int hj = h * 64 + tid;
        cf[CK_MU_R * 64 + tid] = P.mu[hj]; cf[CK_MU_K * 64 + tid] = P.mu[1024 + hj]; cf[CK_MU_V * 64 + tid] = P.mu[2048 + hj]; cf[CK_MU_WL * 64 + tid] = P.mu[3072 + tid]; cf[CK_MU_AL * 64 + tid] = P.mu[3136 + tid];
        cf[CK_W0 * 64 + tid] = P.w0[hj]; cf[CK_A0 * 64 + tid] = P.a0[hj]; cf[CK_KK * 64 + tid] = P.k_k[hj]; cf[CK_KA * 64 + tid] = P.k_a[hj]; cf[CK_RK * 64 + tid] = P.r_k[hj];
        cf[CK_LNW * 64 + tid] = P.ln_w[hj]; cf[CK_LNB * 64 + tid] = P.ln_b[hj];
        if (tid < 16) *(LAS int*)(lds + CS_FLAGS + 4 * tid) = 0;
    }
    __syncthreads();
    unsigned long long pticks = 0ull;
    if (wid < 2) pticks = scan_consumer(P, lds, b, h, wid, lane);
    else pticks = scan_producer(P, lds, b, h, wid - 2, lane);
    if (PROBE_PHASE >= 22 && PROBE_PHASE < 30) { if (tid == 128) *(LAS unsigned long long*)(lds + CS_END) = pticks; }
    __syncthreads();
    if (PROBE_PHASE >= 22 && PROBE_PHASE < 30) pticks = *(LAS unsigned long long*)(lds + CS_END);
    return pticks;
}

#define XB_TMO      128
#define XB_XCNT(j)  (256  + 64 * (j))
#define XB_XSUB(j)  (1280 + 64 * (j))
#define XB_XGEN(j)  (2304 + 64 * (j))
#define XB_TOP      3328
#define XB_TOPGEN   3392
#define XCD_BAR_WORDS 3456
#define XB_SPIN_CAP (1u << 18)
__device__ __forceinline__ unsigned xb_ld(unsigned* p)              { return __hip_atomic_load(p, __ATOMIC_RELAXED, __HIP_MEMORY_SCOPE_AGENT); }
__device__ __forceinline__ unsigned xb_add(unsigned* p, unsigned v) { return __hip_atomic_fetch_add(p, v, __ATOMIC_RELAXED, __HIP_MEMORY_SCOPE_AGENT); }
__device__ __forceinline__ unsigned xb_xcc_id() { return (unsigned)__builtin_amdgcn_s_getreg((3 << 11) | 20) & 0xFu; }
#define XB_SPIN(cond, bar) do { unsigned _sp = 0; while (cond) { __builtin_amdgcn_s_sleep(1); \
    if ((++_sp & 255u) == 0u) { if (xb_ld(&(bar)[XB_TMO])) break; if (_sp > XB_SPIN_CAP) { atomicAdd(&(bar)[XB_TMO], 1u); break; } } } } while (0)
struct XcdBarrier { unsigned* bar; unsigned x; volatile LAS unsigned* st; };
__device__ __forceinline__ XcdBarrier xcd_barrier_post(unsigned* bar, volatile LAS unsigned* st) {
    XcdBarrier b; b.bar = bar; b.x = xb_xcc_id(); b.st = st;
    if (threadIdx.x == 0) (void)xb_add(&bar[XB_XCNT(b.x)], 1u);
    return b;
}
__device__ __forceinline__ void xcd_barrier_complete(unsigned* bar, unsigned x, unsigned& nloc, unsigned& nx) {
    const unsigned G = gridDim.x * gridDim.y * gridDim.z;
    unsigned sum, cnt, mine, sp = 0u;
    for (;;) {
        sum = 0u; cnt = 0u; mine = 0u;
#pragma unroll
        for (unsigned j = 0; j < 16; ++j) { const unsigned c = xb_ld(&bar[XB_XCNT(j)]); sum += c; cnt += (c > 0u) ? 1u : 0u; mine = (j == x) ? c : mine; }
        if (sum == G) break;
        __builtin_amdgcn_s_sleep(1);
        if ((++sp & 255u) == 0u) { if (xb_ld(&bar[XB_TMO])) break; if (sp > XB_SPIN_CAP) { atomicAdd(&bar[XB_TMO], 1u); break; } }
    }
    nloc = mine > 0u ? mine : 1u; nx = cnt > 0u ? cnt : 1u;
}
__device__ __forceinline__ void xcd_barrier(const XcdBarrier& b) {
    asm volatile("s_waitcnt vmcnt(0)" ::: "memory");
    __syncthreads();
    if (threadIdx.x == 0) {
        unsigned* bar = b.bar;
        __builtin_amdgcn_s_waitcnt(0);
        unsigned nloc = b.st[0], nx = b.st[1];
        if (nloc == 0u) { xcd_barrier_complete(bar, b.x, nloc, nx); b.st[0] = nloc; b.st[1] = nx; }
        const unsigned old = xb_add(&bar[XB_XSUB(b.x)], 1u);
        const unsigned gen = old / nloc;
        if (old + 1u == (gen + 1u) * nloc) {
            __builtin_amdgcn_fence(__ATOMIC_RELEASE, "agent");
            asm volatile("s_waitcnt vmcnt(0)" ::: "memory");
            const unsigned og = xb_add(&bar[XB_TOP], 1u);
            const unsigned tg = og / nx;
            if (og + 1u == (tg + 1u) * nx) xb_add(&bar[XB_TOPGEN], 1u);
            else XB_SPIN(xb_ld(&bar[XB_TOPGEN]) == tg, bar);
            __builtin_amdgcn_fence(__ATOMIC_ACQUIRE, "agent");
            xb_add(&bar[XB_XGEN(b.x)], 1u);
            asm volatile("s_waitcnt vmcnt(0)" ::: "memory");
        } else {
            XB_SPIN(xb_ld(&bar[XB_XGEN(b.x)]) == gen, bar);
            __builtin_amdgcn_fence(__ATOMIC_ACQUIRE, "agent");
            asm volatile("s_waitcnt vmcnt(0)" ::: "memory");
        }
    }
    __syncthreads();
}

__device__ __forceinline__ void final_norm(const Params& P, int G) {
    int tid_ = threadIdx.x; asm volatile("" : "+v"(tid_));
    const int lane = tid_ & 63, gw = blockIdx.x * 8 + (tid_ >> 6), NGW = G * 8;
    const float* rowss = (const float*)(P.ws + WS_ROWSS);
    const f32x4* fw = (const f32x4*)P.fnw + lane;
    const f32x4 w0 = fw[0], w1 = fw[64], w2 = fw[128], w3 = fw[192];
    for (int r0 = gw * 2; r0 < MREAL; r0 += NGW * 2) {
        f32x4 v[2][4]; float rs[2];
#pragma unroll
        for (int k = 0; k < 2; ++k) { f32x4* o = (f32x4*)(P.out + (size_t)(r0 + k) * 1024) + lane; rs[k] = rowss[r0 + k];
#pragma unroll
            for (int j = 0; j < 4; ++j) v[k][j] = o[64 * j]; }
#pragma unroll
        for (int k = 0; k < 2; ++k) { f32x4* o = (f32x4*)(P.out + (size_t)(r0 + k) * 1024) + lane; const float rstd = __builtin_amdgcn_rsqf(rs[k] * (1.f / DM) + RMS_EPS);
            o[0] = v[k][0] * rstd * w0; o[64] = v[k][1] * rstd * w1; o[128] = v[k][2] * rstd * w2; o[192] = v[k][3] * rstd * w3; }
    }
}

__global__ void __launch_bounds__(512, 2) fwd_megakernel(Params P) {
    extern __shared__ __attribute__((aligned(16))) unsigned char lds_raw[];
    LAS unsigned char* lds = (LAS unsigned char*)lds_raw;
    cg::grid_group grid = cg::this_grid();
    const int G = gridDim.x;
    if (threadIdx.x < 16) ((LAS unsigned*)(lds + LDS_BARST))[threadIdx.x] = 0u;
    __syncthreads();
    const XcdBarrier bar = xcd_barrier_post((unsigned*)(P.ws + WS_CTL), (volatile LAS unsigned*)(lds + LDS_BARST));
    unsigned long long probe_wait = 0ull, probe_t0 = 0ull;
    const unsigned long long probe_k0 = (PROBE_PHASE == 8) ? __builtin_amdgcn_s_memrealtime() : 0ull;
#define PROBE_BEGIN(k) do { if (PROBE_PHASE == (k)) probe_t0 = __builtin_amdgcn_s_memrealtime(); } while (0)
#define PROBE_END(k) do { if (PROBE_PHASE == (k)) probe_wait += __builtin_amdgcn_s_memrealtime() - probe_t0; } while (0)
#define XBAR() do { PROBE_BEGIN(7); xcd_barrier(bar); PROBE_END(7); } while (0)
    bf16_t* U = (bf16_t*)(P.ws + WS_U); bf16_t* Q = (bf16_t*)(P.ws + WS_Q); bf16_t* RW = (bf16_t*)(P.ws + WS_RW);
    const bf16_t* WinT = (const bf16_t*)(P.ws + WS_WIN); const bf16_t* WbT = (const bf16_t*)(P.ws + WS_WB); const bf16_t* WoT = (const bf16_t*)(P.ws + WS_WOUT);
    bf16_t* SG = (bf16_t*)P.out;
    constexpr int NG_P2 = 1792;
    PROBE_BEGIN(0);
    if (PHASE_MASK & 1) p0_prologue(P, lds, G);
    PROBE_END(0);
    if (gridDim.y != 1) { __builtin_amdgcn_fence(__ATOMIC_SEQ_CST, "agent"); grid.sync(); __builtin_amdgcn_fence(__ATOMIC_SEQ_CST, "agent"); }
    XBAR();
    PROBE_BEGIN(1);
    if (PHASE_MASK & 2) {
        pg8::Gemm g{U, U, WinT, 1024, 1 << 30};
        pg8::StaticOrder S; S.init(MPAD, NP1, G, (int)blockIdx.x);
        EpiP1 E{Q, (bf16_t*)(P.ws + WS_KV), (bf16_t*)(P.ws + WS_RKV), (bf16_t*)(P.ws + WS_WA), (const float*)(P.ws + WS_ROPE)};
        pg8::gemm_phase<EpiP1, pg8::StaticOrder, true>(lds, g, S, E);
    }
    PROBE_END(1);
    XBAR();
    PROBE_BEGIN(2);
    if (G == 256) {
        if (blockIdx.x < 128) { if (PHASE_MASK & 4) { const unsigned long long pt_ = scan_item_chunked(P, lds, blockIdx.x); if (PROBE_PHASE >= 20 && PROBE_PHASE < 30) probe_wait += pt_; } }
        else {
            if (PHASE_MASK & 8) for (int u = blockIdx.x - 128; u < 1024; u += 128) attn_unit(P, lds, u);
            __syncthreads();
            if (PHASE_MASK & 0x10) {
                pg8::Gemm g{U, U, WinT + (size_t)(NP1 + 2048) * 1024, 1024, 1 << 30};
                pg8::StaticOrder S; S.init(MREAL, 2048, 128, (int)blockIdx.x - 128); S.range(0, NG_P2);
                EpiGate E{Q, RW, SG, 8};
                pg8::gemm_phase<EpiGate, pg8::StaticOrder, true>(lds, g, S, E);
            }
        }
    } else {
        for (int it = blockIdx.x; it < 128 + 1024; it += G) { if (it < 128) { if (PHASE_MASK & 4) scan_item_chunked(P, lds, it); } else { if (PHASE_MASK & 8) attn_unit(P, lds, it - 128); } }
    }
    PROBE_END(2);
    XBAR();
    PROBE_BEGIN(3);
    if (PHASE_MASK & 0x10) {
        {
            pg8::Gemm g{U, U, WinT + (size_t)(NP1 + 2048) * 1024, 1024, 1 << 30};
            pg8::StaticOrder S; S.init(MREAL, 2048, G, (int)blockIdx.x); S.range(G == 256 ? NG_P2 : 0, 2048);
            EpiGate E{Q, RW, SG, 8};
            pg8::gemm_phase<EpiGate, pg8::StaticOrder, true>(lds, g, S, E);
        }
        {
            pg8::Gemm g{U, U, WinT + (size_t)NP1 * 1024, 1024, 1 << 30};
            pg8::StaticOrder S; S.init(MREAL, 2048, G, (int)blockIdx.x);
            EpiGate E{Q, RW, SG, 0};
            pg8::gemm_phase<EpiGate, pg8::StaticOrder, true>(lds, g, S, E);
        }
    }
    PROBE_END(3);
    XBAR();
    PROBE_BEGIN(4);
    if (PHASE_MASK & 0x20) {
        pg8::Gemm g{Q, Q, WbT, 1024, 1 << 30};
        pg8::StaticOrder S; S.init(MREAL, 1024, G, (int)blockIdx.x);
        EpiBranch E{U, SG, 0};
        pg8::gemm_phase<EpiBranch, pg8::StaticOrder, true>(lds, g, S, E);
    }
    XBAR();
    if (PHASE_MASK & 0x20) {
        pg8::Gemm g{RW, RW, WbT + (size_t)1024 * 1024, 1024, 1 << 30};
        pg8::StaticOrder S; S.init(MREAL, 1024, G, (int)blockIdx.x);
        EpiBranch E{U, SG, 4};
        pg8::gemm_phase<EpiBranch, pg8::StaticOrder, true>(lds, g, S, E);
    }
    PROBE_END(4);
    XBAR();
    PROBE_BEGIN(5);
    if (PHASE_MASK & 0x40) {
        pg8::Gemm g{U, U, WoT, 1024, 1 << 30};
        pg8::StaticOrder S; S.init(MREAL, 1024, G, (int)blockIdx.x);
        EpiOut E{P.x, P.out, (float*)(P.ws + WS_ROWSS)};
        pg8::gemm_phase<EpiOut, pg8::StaticOrder, true>(lds, g, S, E);
    }
    PROBE_END(5);
    XBAR();
    PROBE_BEGIN(6);
    if (PHASE_MASK & 0x80) final_norm(P, G);
    PROBE_END(6);
    if (PROBE_PHASE == 8) probe_wait = __builtin_amdgcn_s_memrealtime() - probe_k0;
    if (PROBE_PHASE >= 0 && blockIdx.x == PROBE_BLOCK && threadIdx.x == 0) {
        const unsigned long long t = __builtin_amdgcn_s_memrealtime();
        while (__builtin_amdgcn_s_memrealtime() - t < probe_wait) __builtin_amdgcn_s_sleep(8);
    }
}

extern "C" void kernel_launch(void* const* d_in, const int* in_sizes, int n_in, void* d_out, int out_size, void* d_ws, size_t ws_size, hipStream_t stream) {
    static int grid = 0;
    if (grid == 0) {
        if (n_in != 19 || in_sizes[0] != MREAL * DM || out_size != MREAL * DM || ws_size < WS_END) {
            fprintf(stderr, "kernel_launch: unexpected shapes (n_in %d, in0 %d, out %d, ws %zu); nothing launched\n", n_in, n_in > 0 ? in_sizes[0] : -1, out_size, ws_size); grid = -1; return; }
        int dev = 0, cus = 0, per_cu = 0;
        hipGetDevice(&dev);
        hipDeviceGetAttribute(&cus, hipDeviceAttributeMultiprocessorCount, dev);
        hipFuncSetAttribute((const void*)fwd_megakernel, hipFuncAttributeMaxDynamicSharedMemorySize, LDS_BYTES);
        hipOccupancyMaxActiveBlocksPerMultiprocessor(&per_cu, (const void*)fwd_megakernel, 512, LDS_BYTES);
        if (per_cu < 1) { fprintf(stderr, "kernel_launch: occupancy query says %d blocks per CU\n", per_cu); per_cu = 1; }
        grid = cus * 1;
        if (grid > 256) grid = 256;
        (void)hipGetLastError();
    }
    if (grid < 0) return;
    if (hipMemsetAsync((char*)d_ws + WS_CTL, 0, CTL_ZERO_BYTES, stream) != hipSuccess) { fprintf(stderr, "kernel_launch: hipMemsetAsync failed\n"); return; }
    Params p{};
    p.x = (const float*)d_in[0]; p.meta = (const float*)d_in[1]; p.norm_w = (const float*)d_in[2]; p.w_in = (const float*)d_in[3]; p.sinks = (const float*)d_in[4];
    p.mu = (const float*)d_in[5]; p.w0 = (const float*)d_in[6]; p.w2 = (const float*)d_in[7]; p.a0 = (const float*)d_in[8]; p.a2 = (const float*)d_in[9];
    p.k_k = (const float*)d_in[10]; p.k_a = (const float*)d_in[11]; p.r_k = (const float*)d_in[12]; p.ln_w = (const float*)d_in[13]; p.ln_b = (const float*)d_in[14];
    p.w_ba = (const float*)d_in[15]; p.w_br = (const float*)d_in[16]; p.w_out = (const float*)d_in[17]; p.fnw = (const float*)d_in[18];
    p.out = (float*)d_out; p.ws = (unsigned char*)d_ws;
    void* args[] = {&p};
    hipError_t e = hipLaunchCooperativeKernel((const void*)fwd_megakernel, dim3(grid), dim3(512), args, LDS_BYTES, stream);
    if (e != hipSuccess) fprintf(stderr, "cooperative launch failed: %s (grid %d)\n", hipGetErrorString(e), grid);
}
```

```cpp
#include <hip/hip_runtime.h>
#include <hip/hip_cooperative_groups.h>
#include <cstdio>
#include <cstdint>
namespace cg = cooperative_groups;
#ifndef PROBE_PHASE
#define PROBE_PHASE -1
#endif
#ifndef PROBE_BLOCK
#define PROBE_BLOCK 0
#endif
#ifndef PHASE_MASK
#define PHASE_MASK 0xFF
#endif

#define LAS __attribute__((address_space(3)))
typedef unsigned short bf16_t;
typedef short bf16x8 __attribute__((ext_vector_type(8)));
typedef short s16x4 __attribute__((ext_vector_type(4)));
typedef float f32x4 __attribute__((ext_vector_type(4)));
typedef float f32x16 __attribute__((ext_vector_type(16)));
typedef unsigned u32x4 __attribute__((ext_vector_type(4)));
typedef unsigned u32x2 __attribute__((ext_vector_type(2)));

constexpr int DM = 1024, NB = 8, SEQ = 8192, NMETA = 16, TT = SEQ + NMETA;
constexpr int MREAL = NB * SEQ;
constexpr int MPAD = MREAL + 256;
constexpr int NIN_SRC = 8576, NIN = 8704;
constexpr int NP1 = 4608;
constexpr float RMS_EPS = 1e-6f, GN_EPS = 64e-5f;
constexpr float LOG2E = 1.4426950408889634f;
constexpr float QSCALE = 0.125f * LOG2E;

constexpr size_t MiB = 1u << 20;
constexpr size_t WS_CTL = 0, CTL_ZERO_BYTES = 1 * MiB;
constexpr size_t WS_ROWSS = 512 * 1024;
constexpr size_t WS_WIN = 1 * MiB;
constexpr size_t WS_WB = 18 * MiB;
constexpr size_t WS_WOUT = 22 * MiB;
constexpr size_t WS_ROPE = 24 * MiB;
constexpr size_t WS_U = 27 * MiB;
constexpr size_t WS_Q = 156 * MiB;
constexpr size_t WS_KV = 285 * MiB;
constexpr size_t WS_RKV = 318 * MiB;
constexpr size_t WS_WA = 704 * MiB;
constexpr size_t WS_RW = 721 * MiB;
constexpr size_t WS_END = 849 * MiB;

constexpr int LDS_STAGE = 131072;
constexpr int LDS_BARST = 163840 - 64;
constexpr int LDS_BYTES = 163840;

typedef float f32x2_t __attribute__((ext_vector_type(2))); typedef __bf16 bf16x2_t __attribute__((ext_vector_type(2)));
__device__ __forceinline__ unsigned cvt_pk_bf16(float lo, float hi) { const f32x2_t v = {lo, hi}; const bf16x2_t b = __builtin_convertvector(v, bf16x2_t); return __builtin_bit_cast(unsigned, b); }
__device__ __forceinline__ float bf2f(unsigned short b) { return __uint_as_float((unsigned)b << 16); }
__device__ __forceinline__ float bflo(unsigned w) { return __uint_as_float(w << 16); }
__device__ __forceinline__ float bfhi(unsigned w) { return __uint_as_float(w & 0xffff0000u); }
__device__ __forceinline__ unsigned short f2bf(float f) { return (unsigned short)(cvt_pk_bf16(f, 0.f) & 0xffffu); }
__device__ __forceinline__ float wave_sum(float v) {
#pragma unroll
    for (int o = 1; o < 64; o <<= 1) v += __shfl_xor(v, o);
    return v;
}
template <int CTRL> __device__ __forceinline__ float dppf(float v) {
    return __builtin_bit_cast(float, __builtin_amdgcn_update_dpp(0, __builtin_bit_cast(int, v), CTRL, 0xF, 0xF, true));
}
__device__ __forceinline__ float red8(float v) {
    v += dppf<0xB1>(v);
    v += dppf<0x4E>(v);
    v += dppf<0x141>(v);
    return v;
}
__device__ __forceinline__ float sigmoidf_(float x) { return __builtin_amdgcn_rcpf(1.f + __builtin_amdgcn_exp2f(-x * LOG2E)); }
__device__ __forceinline__ float siluf_(float x) { return x * sigmoidf_(x); }

namespace pg8 {
constexpr int BM = 256, BK = 64, HALF = 128, HTB = HALF * BK * 2, STAGE_BYTES = 8 * HTB, NXCD = 8, WGM = 8;
__host__ __device__ __forceinline__ int lds_byte(int r, int c) { const int st = (r >> 4) * 2 + (c >> 5), rr = r & 15, cc = c & 31, ob = rr * 64 + cc * 2; return st * 1024 + (ob ^ (((ob >> 9) & 1) << 5)); }
__host__ __device__ __forceinline__ void stage_rc(int b, int& R, int& C) { const int st = b / 1024, sb = b % 1024, swz = sb ^ (((sb >> 9) & 1) << 5); R = (st >> 1) * 16 + swz / 64; C = (st & 1) * 32 + (swz % 64) / 2; }
__host__ __device__ __forceinline__ int perm32(int rho) { const int n = rho >> 4, i = rho & 15; return 8 * (i >> 2) + 4 * n + (i & 3); }

struct Unit { int pm, pn; };
struct Gemm { const bf16_t* A; const bf16_t* A2; const bf16_t* Bt; int K; int asplit; };

struct StaticOrder {
    int nM, nN, nwg, G, c, L0, L1;
    __device__ void init(int M, int N, int G_, int c_) { nM = M / BM; nN = N / BM; nwg = nM * nN; G = G_; c = c_; L0 = 0; L1 = nwg; asm volatile("" : "+s"(L1)); }
    __device__ void range(int a, int b) { L0 = a; L1 = b; asm volatile("" : "+s"(L1)); }
    __device__ bool next(int i, Unit& u) const {
        const long L = (long)L0 + (long)i * G + c; if (L >= L1) return false;
        int wgid = (int)L; { const int q = nwg / NXCD, r = nwg % NXCD, xcd = wgid % NXCD, off = wgid / NXCD; wgid = (xcd < r ? xcd * (q + 1) : r * (q + 1) + (xcd - r) * q) + off; }
        const int nig = WGM * nN, gid = wgid / nig, fm = gid * WGM, gsz = (nM - fm) < WGM ? (nM - fm) : WGM;
        u.pm = fm + ((wgid % nig) % gsz); u.pn = (wgid % nig) / gsz; return true;
    }
};
template <class Epi, class Sched, bool ALIGN_EPI>
__device__ __forceinline__ void gemm_phase(LAS unsigned char* lds, const Gemm g, const Sched& S, const Epi& E) {
    int tid_ = threadIdx.x; asm volatile("" : "+v"(tid_));
    const int tid = tid_, wid = __builtin_amdgcn_readfirstlane(tid >> 6), lane = tid & 63, wr = wid >> 2, wc = wid & 3, fr = lane & 15, fq = lane >> 4;
    const int K = g.K, nt = K / BK;
    unsigned voffA[2], voffB[2];
#pragma unroll
    for (int i = 0; i < 2; ++i) { int R, C; stage_rc(tid * 16 + i * 8192, R, C); const int Rb = Epi::PERM ? ((R & ~31) + perm32(R & 31)) : R;
        voffA[i] = (unsigned)(R * K + C) * 2u; voffB[i] = (unsigned)(Rb * K + C) * 2u; }
    const size_t kstep = (size_t)(BK * 2);
    const size_t hstep = (size_t)HALF * K * 2;
    const size_t tstep = 2 * hstep;
    const unsigned ldsw = (unsigned)wid * 1024u;
    const int aoff = lds_byte(wr * 64 + fr, fq * 8), boff = lds_byte(wc * 32 + fr, fq * 8);
#define PG8_SA(b, h) (((b) * 2 + (h)) * HTB)
#define PG8_SB(b, h) ((4 + (b) * 2 + (h)) * HTB)
#define PG8_STAGE(bufoff, gbase, voff) do { _Pragma("unroll") for (int _i = 0; _i < 2; ++_i) \
        __builtin_amdgcn_global_load_lds((const unsigned*)((const char*)(gbase) + (voff)[_i]), (LAS unsigned*)(lds + (bufoff) + ldsw + _i * 8192), 16, 0, 0); } while (0)
#define PG8_LDA(dst, b, h) do { _Pragma("unroll") for (int m = 0; m < 4; ++m) _Pragma("unroll") for (int k = 0; k < 2; ++k) dst[m][k] = *(const LAS bf16x8*)(lds + PG8_SA(b, h) + aoff + m * 2048 + k * 1024); } while (0)
#define PG8_LDB(dst, b, h) do { _Pragma("unroll") for (int n = 0; n < 2; ++n) _Pragma("unroll") for (int k = 0; k < 2; ++k) dst[n][k] = *(const LAS bf16x8*)(lds + PG8_SB(b, h) + boff + n * 2048 + k * 1024); } while (0)
#define PG8_MMA(ai, bj, At, Bt) do { __builtin_amdgcn_s_setprio(1); _Pragma("unroll") for (int m = 0; m < 4; ++m) _Pragma("unroll") for (int n = 0; n < 2; ++n) _Pragma("unroll") for (int k = 0; k < 2; ++k) \
        acc[ai][bj][m][n] = __builtin_amdgcn_mfma_f32_16x16x32_bf16(Bt[n][k], At[m][k], acc[ai][bj][m][n], 0, 0, 0); __builtin_amdgcn_s_setprio(0); } while (0)
#define PG8_WAIT_V(n) asm volatile("s_waitcnt vmcnt(" #n ")" ::: "memory")
#define PG8_WAIT_L(n) asm volatile("s_waitcnt lgkmcnt(" #n ")" ::: "memory")
#define PG8_BAR __builtin_amdgcn_s_barrier()
#define PG8_SCHED __builtin_amdgcn_sched_barrier(0)
#define PG8_APTR(u) ((const char*)((u).pn >= g.asplit ? g.A2 : g.A) + (size_t)(u).pm * tstep)
#define PG8_BPTR(u) ((const char*)g.Bt + (size_t)(u).pn * tstep)
    Unit cur, nxt; int ui = 0;
    if (!S.next(0, cur)) return;
    f32x4 acc[2][2][4][2];
#pragma unroll
    for (int a = 0; a < 2; ++a)
#pragma unroll
        for (int b = 0; b < 2; ++b)
#pragma unroll
            for (int m = 0; m < 4; ++m)
#pragma unroll
                for (int n = 0; n < 2; ++n) acc[a][b][m][n] = (f32x4){0.f, 0.f, 0.f, 0.f};
    bf16x8 At[4][2], B0[2][2], B1[2][2];
    const char* cA = PG8_APTR(cur); const char* cB = PG8_BPTR(cur);
    PG8_STAGE(PG8_SB(0, 0), cB, voffB); PG8_STAGE(PG8_SB(0, 1), cB + hstep, voffB); PG8_STAGE(PG8_SA(0, 0), cA, voffA); PG8_STAGE(PG8_SA(0, 1), cA + hstep, voffA);
    if (wr == 1) PG8_BAR;
    PG8_WAIT_V(2); PG8_BAR;
    PG8_STAGE(PG8_SB(1, 0), cB + kstep, voffB); PG8_STAGE(PG8_SA(1, 0), cA + kstep, voffA); PG8_STAGE(PG8_SB(1, 1), cB + hstep + kstep, voffB);
    PG8_WAIT_V(6); PG8_BAR;
    for (;;) {
        const bool has_next = S.next(ui + 1, nxt);
        const char* nA = has_next ? PG8_APTR(nxt) : cA; const char* nB = has_next ? PG8_BPTR(nxt) : cB;
        for (int t = 0; t < nt; t += 2) {
            const bool last = (t == nt - 2);
            const char* a1 = cA + (size_t)(t + 1) * kstep;
            const char* a2 = last ? nA : cA + (size_t)(t + 2) * kstep; const char* b2 = last ? nB : cB + (size_t)(t + 2) * kstep;
            const char* a3 = a2 + kstep; const char* b3 = b2 + kstep;
            PG8_LDB(B0, 0, 0); PG8_LDB(B1, 0, 1); PG8_SCHED; PG8_LDA(At, 0, 0); PG8_STAGE(PG8_SA(1, 1), a1 + hstep, voffA);
            PG8_WAIT_V(8); PG8_WAIT_L(0); PG8_BAR; PG8_MMA(0, 0, At, B0); PG8_MMA(0, 1, At, B1); PG8_BAR; PG8_SCHED;
            PG8_LDA(At, 0, 1); PG8_STAGE(PG8_SB(0, 0), b2, voffB); PG8_STAGE(PG8_SB(0, 1), b2 + hstep, voffB); PG8_STAGE(PG8_SA(0, 0), a2, voffA);
            PG8_WAIT_V(8); PG8_WAIT_L(0); PG8_BAR; PG8_MMA(1, 0, At, B0); PG8_MMA(1, 1, At, B1); PG8_BAR; PG8_SCHED;
            PG8_LDB(B0, 1, 0); PG8_LDB(B1, 1, 1); PG8_SCHED; PG8_LDA(At, 1, 0); PG8_STAGE(PG8_SA(0, 1), a2 + hstep, voffA);
            PG8_WAIT_V(8); PG8_WAIT_L(0); PG8_BAR; PG8_MMA(0, 0, At, B0); PG8_MMA(0, 1, At, B1); PG8_BAR; PG8_SCHED;
            PG8_LDA(At, 1, 1); PG8_STAGE(PG8_SB(1, 0), b3, voffB); PG8_STAGE(PG8_SB(1, 1), b3 + hstep, voffB); PG8_STAGE(PG8_SA(1, 0), a3, voffA);
            PG8_WAIT_V(8); PG8_WAIT_L(0); PG8_BAR; PG8_MMA(1, 0, At, B0); PG8_MMA(1, 1, At, B1); PG8_BAR; PG8_SCHED;
        }
        if constexpr (ALIGN_EPI) { if (wr == 0) PG8_BAR; }
        E(acc, cur, wr, wc, fr, fq);
        if (!has_next) break;
#pragma unroll
        for (int a = 0; a < 2; ++a)
#pragma unroll
            for (int b = 0; b < 2; ++b)
#pragma unroll
                for (int m = 0; m < 4; ++m)
#pragma unroll
                    for (int n = 0; n < 2; ++n) acc[a][b][m][n] = (f32x4){0.f, 0.f, 0.f, 0.f};
        cur = nxt; cA = nA; cB = nB; ++ui;
        if constexpr (ALIGN_EPI) { if (wr == 1) PG8_BAR; }
    }
    PG8_WAIT_V(0);
    if constexpr (!ALIGN_EPI) { if (wr == 0) PG8_BAR; }
    PG8_BAR;
#undef PG8_SA
#undef PG8_SB
#undef PG8_STAGE
#undef PG8_LDA
#undef PG8_LDB
#undef PG8_MMA
#undef PG8_WAIT_V
#undef PG8_WAIT_L
#undef PG8_BAR
#undef PG8_SCHED
#undef PG8_APTR
#undef PG8_BPTR
}
}

struct Params {
    const float* x; const float* meta; const float* norm_w; const float* w_in; const float* sinks; const float* mu; const float* w0; const float* w2;
    const float* a0; const float* a2; const float* k_k; const float* k_a; const float* r_k; const float* ln_w; const float* ln_b;
    const float* w_ba; const float* w_br; const float* w_out; const float* fnw;
    float* out; unsigned char* ws;
};

struct EpiP1 {
    static constexpr bool PERM = true;
    bf16_t *Q, *KV, *RKV, *WA; const float* rope;
    __device__ __forceinline__ void operator()(const f32x4 (&acc)[2][2][4][2], const pg8::Unit& u, int wr, int wc, int fr, int fq) const {
        asm volatile("" : "+v"(fr), "+v"(fq));
        const int pn = u.pn, row0 = u.pm * 256 + wr * 64 + fr, cl = wc * 32 + 8 * fq;
        if (pn <= 4) {
            const float sc = pn < 4 ? QSCALE : 1.f;
#pragma unroll
            for (int ai = 0; ai < 2; ++ai)
#pragma unroll
                for (int m = 0; m < 4; ++m) {
                    const int row = row0 + ai * 128 + m * 16;
                    const int pos = row < MREAL ? (row & (SEQ - 1)) + NMETA : row - MREAL;
                    const float* rp = rope + (size_t)pos * 64;
#pragma unroll
                    for (int bj = 0; bj < 2; ++bj) {
                        const int col = bj * 128 + cl;
                        f32x4 v0 = acc[ai][bj][m][0], v1 = acc[ai][bj][m][1];
                        u32x4 w;
                        if (pn == 4 && bj == 1) {
                            w.x = cvt_pk_bf16(v0[0], v0[1]); w.y = cvt_pk_bf16(v0[2], v0[3]); w.z = cvt_pk_bf16(v1[0], v1[1]); w.w = cvt_pk_bf16(v1[2], v1[3]);
                        } else {
                            const int i0 = (col & 63) >> 1;
                            const f32x4 c = *(const f32x4*)(rp + i0), s = *(const f32x4*)(rp + 32 + i0);
                            w.x = cvt_pk_bf16((v0[0] * c[0] - v0[1] * s[0]) * sc, (v0[1] * c[0] + v0[0] * s[0]) * sc);
                            w.y = cvt_pk_bf16((v0[2] * c[1] - v0[3] * s[1]) * sc, (v0[3] * c[1] + v0[2] * s[1]) * sc);
                            w.z = cvt_pk_bf16((v1[0] * c[2] - v1[1] * s[2]) * sc, (v1[1] * c[2] + v1[0] * s[2]) * sc);
                            w.w = cvt_pk_bf16((v1[2] * c[3] - v1[3] * s[3]) * sc, (v1[3] * c[3] + v1[2] * s[3]) * sc);
                        }
                        bf16_t* dst = pn < 4 ? Q + (size_t)row * 1024 + pn * 256 + col : KV + (size_t)row * 256 + col;
                        *(u32x4*)dst = w;
                    }
                }
        } else {
#pragma unroll
            for (int ai = 0; ai < 2; ++ai)
#pragma unroll
                for (int m = 0; m < 4; ++m) {
                    const int row = row0 + ai * 128 + m * 16;
#pragma unroll
                    for (int bj = 0; bj < 2; ++bj) {
                        const int col = bj * 128 + cl;
                        const f32x4 v0 = acc[ai][bj][m][0], v1 = acc[ai][bj][m][1];
                        u32x4 w; w.x = cvt_pk_bf16(v0[0], v0[1]); w.y = cvt_pk_bf16(v0[2], v0[3]); w.z = cvt_pk_bf16(v1[0], v1[1]); w.w = cvt_pk_bf16(v1[2], v1[3]);
                        if (pn < 17) *(u32x4*)(RKV + (size_t)row * 3072 + (pn - 5) * 256 + col) = w;
                        else if (bj == 0) *(u32x4*)(WA + (size_t)row * 128 + col) = w;
                    }
                }
        }
    }
};
struct EpiGate {
    static constexpr bool PERM = true;
    bf16_t *Q, *RW, *SG; int pn_off;
    __device__ __forceinline__ void operator()(const f32x4 (&acc)[2][2][4][2], const pg8::Unit& u, int wr, int wc, int fr, int fq) const {
        asm volatile("" : "+v"(fr), "+v"(fq));
        const int pn = u.pn + pn_off, row0 = u.pm * 256 + wr * 64 + fr, cl = wc * 32 + 8 * fq;
#pragma unroll
        for (int ai = 0; ai < 2; ++ai)
#pragma unroll
            for (int m = 0; m < 4; ++m) {
                const int row = row0 + ai * 128 + m * 16;
#pragma unroll
                for (int bj = 0; bj < 2; ++bj) {
                    const int col = bj * 128 + cl;
                    const f32x4 v0 = acc[ai][bj][m][0], v1 = acc[ai][bj][m][1];
                    u32x4 w;
                    if (pn < 8) {
                        bf16_t* p = (pn < 4 ? Q + (size_t)row * 1024 + pn * 256 : RW + (size_t)row * 1024 + (pn - 4) * 256) + col;
                        const u32x4 a = *(const u32x4*)p;
                        w.x = cvt_pk_bf16(bflo(a.x) * siluf_(v0[0]), bfhi(a.x) * siluf_(v0[1]));
                        w.y = cvt_pk_bf16(bflo(a.y) * siluf_(v0[2]), bfhi(a.y) * siluf_(v0[3]));
                        w.z = cvt_pk_bf16(bflo(a.z) * siluf_(v1[0]), bfhi(a.z) * siluf_(v1[1]));
                        w.w = cvt_pk_bf16(bflo(a.w) * siluf_(v1[2]), bfhi(a.w) * siluf_(v1[3]));
                        *(u32x4*)p = w;
                    } else {
                        w.x = cvt_pk_bf16(sigmoidf_(v0[0]), sigmoidf_(v0[1])); w.y = cvt_pk_bf16(sigmoidf_(v0[2]), sigmoidf_(v0[3]));
                        w.z = cvt_pk_bf16(sigmoidf_(v1[0]), sigmoidf_(v1[1])); w.w = cvt_pk_bf16(sigmoidf_(v1[2]), sigmoidf_(v1[3]));
                        *(u32x4*)(SG + (size_t)row * 2048 + (pn - 8) * 256 + col) = w;
                    }
                }
                asm volatile("" ::: "memory");
            }
    }
};
struct EpiBranch {
    static constexpr bool PERM = true;
    bf16_t* MG; const bf16_t* SG; int pn_off;
    __device__ __forceinline__ void operator()(const f32x4 (&acc)[2][2][4][2], const pg8::Unit& u, int wr, int wc, int fr, int fq) const {
        asm volatile("" : "+v"(fr), "+v"(fq));
        const int pn = u.pn + pn_off, pc = pn & 3, row0 = u.pm * 256 + wr * 64 + fr, cl = wc * 32 + 8 * fq;
        const unsigned so0 = (unsigned)row0 * 2048u + (unsigned)((pn >= 4 ? 1024 : 0) + pc * 256 + cl), mo0 = (unsigned)row0 * 1024u + (unsigned)(pc * 256 + cl);
#pragma unroll
        for (int ai = 0; ai < 2; ++ai)
#pragma unroll
            for (int mh = 0; mh < 2; ++mh) {
                u32x4 sg[2][2], pa[2][2];
#pragma unroll
                for (int mm = 0; mm < 2; ++mm)
#pragma unroll
                    for (int bj = 0; bj < 2; ++bj) { const int m = 2 * mh + mm;
                        sg[mm][bj] = *(const u32x4*)(SG + (so0 + (unsigned)((ai * 128 + m * 16) * 2048 + bj * 128)));
                        if (pn >= 4) pa[mm][bj] = *(const u32x4*)(MG + (mo0 + (unsigned)((ai * 128 + m * 16) * 1024 + bj * 128))); else pa[mm][bj] = (u32x4){0u, 0u, 0u, 0u}; }
#pragma unroll
                for (int mm = 0; mm < 2; ++mm)
#pragma unroll
                    for (int bj = 0; bj < 2; ++bj) { const int m = 2 * mh + mm;
                        const f32x4 v0 = acc[ai][bj][m][0], v1 = acc[ai][bj][m][1]; const u32x4 sv = sg[mm][bj], a = pa[mm][bj];
                        u32x4 w;
                        w.x = cvt_pk_bf16(bflo(sv.x) * v0[0] + bflo(a.x), bfhi(sv.x) * v0[1] + bfhi(a.x));
                        w.y = cvt_pk_bf16(bflo(sv.y) * v0[2] + bflo(a.y), bfhi(sv.y) * v0[3] + bfhi(a.y));
                        w.z = cvt_pk_bf16(bflo(sv.z) * v1[0] + bflo(a.z), bfhi(sv.z) * v1[1] + bfhi(a.z));
                        w.w = cvt_pk_bf16(bflo(sv.w) * v1[2] + bflo(a.w), bfhi(sv.w) * v1[3] + bfhi(a.w));
                        *(u32x4*)(MG + (mo0 + (unsigned)((ai * 128 + m * 16) * 1024 + bj * 128))) = w;
                    }
                asm volatile("" ::: "memory");
            }
    }
};
struct EpiOut {
    static constexpr bool PERM = false;
    const float* x; float* out; float* rowss;
    __device__ __forceinline__ void operator()(const f32x4 (&acc)[2][2][4][2], const pg8::Unit& u, int wr, int wc, int fr, int fq) const {
        asm volatile("" : "+v"(fr), "+v"(fq));
        const int row0 = u.pm * 256 + wr * 64 + fr, col0 = u.pn * 256 + wc * 32 + 4 * fq;
        const unsigned xo0 = (unsigned)row0 * 1024u + (unsigned)col0;
#pragma unroll
        for (int ai = 0; ai < 2; ++ai)
#pragma unroll
            for (int mh = 0; mh < 2; ++mh) {
                f32x4 xl[2][2][2];
#pragma unroll
                for (int mm = 0; mm < 2; ++mm)
#pragma unroll
                    for (int bj = 0; bj < 2; ++bj)
#pragma unroll
                        for (int n = 0; n < 2; ++n) xl[mm][bj][n] = *(const f32x4*)(x + (xo0 + (unsigned)((ai * 128 + (2 * mh + mm) * 16) * 1024 + bj * 128 + n * 16)));
#pragma unroll
                for (int mm = 0; mm < 2; ++mm) { const int m = 2 * mh + mm;
                    float ss = 0.f;
#pragma unroll
                    for (int bj = 0; bj < 2; ++bj)
#pragma unroll
                        for (int n = 0; n < 2; ++n) {
                            const f32x4 h = xl[mm][bj][n] + acc[ai][bj][m][n];
                            ss += (h[0] * h[0] + h[1] * h[1]) + (h[2] * h[2] + h[3] * h[3]);
                            *(f32x4*)(out + (xo0 + (unsigned)((ai * 128 + m * 16) * 1024 + bj * 128 + n * 16))) = h;
                        }
                    ss += __shfl_xor(ss, 16); ss += __shfl_xor(ss, 32);
                    if (fq == 0) atomicAdd(rowss + row0 + ai * 128 + m * 16, ss);
                }
                asm volatile("" ::: "memory");
            }
    }
};

__device__ __forceinline__ int win_dest(int n) {
    if (n < 1152) { const int hh = n >> 6, d = n & 63; return (hh << 6) + 2 * (d & 31) + (d >> 5); }
    if (n < 1280) return n;
    if (n < 2304) return 4608 + (n - 1280);
    if (n < 5504) return 1280 + (n - 2304);
    if (n < 6528) return 5632 + (n - 5504);
    return 6656 + (n - 6528);
}
template <bool MAPPED>
__device__ __forceinline__ void p0_transpose_item(const float* W, int N, bf16_t* WT, LAS float* scr, int item, int lane) {
    const int nblk = N / 32, kb = item / nblk, nb = item % nblk, k0 = 64 * kb, n0 = 32 * nb;
#pragma unroll 8
    for (int i = 0; i < 32; ++i) { const int kk = 2 * i + (lane >> 5); scr[kk * 33 + (lane & 31)] = W[(size_t)(k0 + kk) * N + n0 + (lane & 31)]; }
    asm volatile("s_waitcnt lgkmcnt(0)" ::: "memory");
    const int c = lane & 7;
#pragma unroll
    for (int j = 0; j < 4; ++j) { const int n = (lane >> 3) + 8 * j; const LAS float* s = scr + (8 * c) * 33 + n;
        u32x4 o; o.x = cvt_pk_bf16(s[0 * 33], s[1 * 33]); o.y = cvt_pk_bf16(s[2 * 33], s[3 * 33]); o.z = cvt_pk_bf16(s[4 * 33], s[5 * 33]); o.w = cvt_pk_bf16(s[6 * 33], s[7 * 33]);
        const int dr = MAPPED ? win_dest(n0 + n) : n0 + n;
        *(u32x4*)(WT + (size_t)dr * 1024 + k0 + 8 * c) = o; }
    asm volatile("s_waitcnt lgkmcnt(0)" ::: "memory");
}
__device__ __forceinline__ void rms_rows2_to_bf16(const float* x0, const float* x1, const float* nw, bf16_t* o0, bf16_t* o1, int lane) {
    const f32x4* xr0 = (const f32x4*)x0 + lane; const f32x4* xr1 = (const f32x4*)x1 + lane; const f32x4* wr4 = (const f32x4*)nw + lane;
    f32x4 v0[4], v1[4]; float s0 = 0.f, s1 = 0.f;
#pragma unroll
    for (int j = 0; j < 4; ++j) { v0[j] = xr0[64 * j]; v1[j] = xr1[64 * j]; }
#pragma unroll
    for (int j = 0; j < 4; ++j) { s0 += (v0[j][0] * v0[j][0] + v0[j][1] * v0[j][1]) + (v0[j][2] * v0[j][2] + v0[j][3] * v0[j][3]); s1 += (v1[j][0] * v1[j][0] + v1[j][1] * v1[j][1]) + (v1[j][2] * v1[j][2] + v1[j][3] * v1[j][3]); }
    const float r0 = 1.f / sqrtf(wave_sum(s0) * (1.f / DM) + RMS_EPS), r1 = 1.f / sqrtf(wave_sum(s1) * (1.f / DM) + RMS_EPS);
    u32x2* p0 = (u32x2*)o0 + lane; u32x2* p1 = (u32x2*)o1 + lane;
#pragma unroll
    for (int j = 0; j < 4; ++j) { const f32x4 w = wr4[64 * j];
        u32x2 a; a.x = cvt_pk_bf16(v0[j][0] * r0 * w[0], v0[j][1] * r0 * w[1]); a.y = cvt_pk_bf16(v0[j][2] * r0 * w[2], v0[j][3] * r0 * w[3]); p0[64 * j] = a;
        u32x2 b; b.x = cvt_pk_bf16(v1[j][0] * r1 * w[0], v1[j][1] * r1 * w[1]); b.y = cvt_pk_bf16(v1[j][2] * r1 * w[2], v1[j][3] * r1 * w[3]); p1[64 * j] = b; }
}
__device__ __forceinline__ void p0_prologue(const Params& P, LAS unsigned char* lds, int G) {
    const int tid = threadIdx.x, lane = tid & 63, wave = tid >> 6;
    LAS float* scr = (LAS float*)(lds + wave * 16384);
    const int gw = blockIdx.x * 8 + wave, NGW = G * 8;
    bf16_t* WinT = (bf16_t*)(P.ws + WS_WIN); bf16_t* WbT = (bf16_t*)(P.ws + WS_WB); bf16_t* WoT = (bf16_t*)(P.ws + WS_WOUT);
    constexpr int I_IN = 16 * (NIN_SRC / 32), I_SQ = 16 * 32;
    for (int it = gw; it < I_IN + 3 * I_SQ; it += NGW) {
        int r = it;
        if (r < I_IN) { p0_transpose_item<true>(P.w_in, NIN_SRC, WinT, scr, r, lane); continue; } r -= I_IN;
        if (r < I_SQ) { p0_transpose_item<false>(P.w_ba, 1024, WbT, scr, r, lane); continue; } r -= I_SQ;
        if (r < I_SQ) { p0_transpose_item<false>(P.w_br, 1024, WbT + (size_t)1024 * 1024, scr, r, lane); continue; } r -= I_SQ;
        p0_transpose_item<false>(P.w_out, 1024, WoT, scr, r, lane);
    }
    for (int i = blockIdx.x * 512 + tid; i < 16384; i += G * 512) *((u32x4*)(WinT + (size_t)4480 * 1024) + i) = (u32x4){0u, 0u, 0u, 0u};
    bf16_t* U = (bf16_t*)(P.ws + WS_U);
    for (int m = 2 * gw; m < MREAL + NMETA; m += 2 * NGW) {
        const float* src = m < MREAL ? P.x + (size_t)m * DM : P.meta + (size_t)(m - MREAL) * DM;
        rms_rows2_to_bf16(src, src + DM, P.norm_w, U + (size_t)m * DM, U + (size_t)(m + 1) * DM, lane);
    }
    float* rope = (float*)(P.ws + WS_ROPE);
    for (int i = blockIdx.x * 512 + tid; i < TT * 32; i += G * 512) {
        const int pos = i >> 5, k = i & 31;
        const double inv = exp(-9.210340371976184 * (double)k / 32.0);
        const double ang = (double)pos * inv;
        rope[pos * 64 + k] = (float)cos(ang); rope[pos * 64 + 32 + k] = (float)sin(ang);
    }
}

__device__ __forceinline__ void p1_meta_tile(const Params& P, int tl, int lane) {
    const int n = lane & 15, g = lane >> 4;
    const bf16_t* U = (const bf16_t*)(P.ws + WS_U) + (size_t)MREAL * 1024;
    const bf16_t* W = (const bf16_t*)(P.ws + WS_WIN) + (size_t)(16 * tl) * 1024;
    f32x4 acc = (f32x4){0.f, 0.f, 0.f, 0.f};
#pragma unroll 1
    for (int kb = 0; kb < 4; ++kb) {
        bf16x8 a[8], bq[8];
#pragma unroll
        for (int s = 0; s < 8; ++s) { a[s] = *(const bf16x8*)(U + (size_t)n * 1024 + 256 * kb + 32 * s + 8 * g); bq[s] = *(const bf16x8*)(W + (size_t)n * 1024 + 256 * kb + 32 * s + 8 * g); }
#pragma unroll
        for (int s = 0; s < 8; ++s) acc = __builtin_amdgcn_mfma_f32_16x16x32_bf16(a[s], bq[s], acc, 0, 0, 0);
    }
    const int dcol = 16 * tl + n;
    const bool roped = dcol < 1152;
    const float* rope = (const float*)(P.ws + WS_ROPE);
    bf16_t* Q = (bf16_t*)(P.ws + WS_Q); bf16_t* KV = (bf16_t*)(P.ws + WS_KV); bf16_t* RKV = (bf16_t*)(P.ws + WS_RKV); bf16_t* WA = (bf16_t*)(P.ws + WS_WA);
#pragma unroll
    for (int r = 0; r < 4; ++r) {
        const int j = 4 * g + r; const size_t row = (size_t)MREAL + j;
        float v = acc[r];
        const float partner = dppf<0xB1>(v);
        if (roped) { const int i = (dcol & 63) >> 1; const float c = rope[j * 64 + i], sn = rope[j * 64 + 32 + i];
            v = (n & 1) ? (v * c + partner * sn) : (v * c - partner * sn);
            if (dcol < 1024) v *= QSCALE; }
        const unsigned short o = f2bf(v);
        if (dcol < 1024) Q[row * 1024 + dcol] = o;
        else if (dcol < 1280) KV[row * 256 + (dcol - 1024)] = o;
        else if (dcol < 4352) RKV[row * 3072 + (dcol - 1280)] = o;
        else WA[row * 128 + (dcol - 4352)] = o;
    }
}

constexpr int KS_STRIDE = 144;
constexpr int VT_STRIDE = 520;
constexpr int ATT_KS = 0, ATT_VT = 256 * KS_STRIDE;
__device__ __forceinline__ int crow(int r, int hi) { return (r & 3) + 8 * (r >> 2) + 4 * hi; }
__device__ __forceinline__ void attn_unit(const Params& P, LAS unsigned char* lds, int unit) {
    int tid_ = threadIdx.x; asm volatile("" : "+v"(tid_));
    const int tid = tid_, lane = tid & 63, wid = tid >> 6, qc = lane & 31, hi = lane >> 5;
    const int g = unit & 1, qb = (unit >> 1) & 63, b = unit >> 7;
    bf16_t* Q = (bf16_t*)(P.ws + WS_Q); const bf16_t* KV = (const bf16_t*)(P.ws + WS_KV);
    const int rb = b * SEQ + qb * 128;
    __syncthreads();
#pragma unroll
    for (int i = 0; i < 4; ++i) {
        const int id = tid + 512 * i, c = id >> 3, ch = id & 7;
        int row; bool ok = true;
        if (c >= 128) row = rb + c - 128; else if (qb > 0) row = rb - 128 + c; else { ok = c >= 112; row = MREAL + c - 112; }
        u32x4 kq = (u32x4){0u, 0u, 0u, 0u}, vq = kq;
        if (ok) { kq = *(const u32x4*)(KV + (size_t)row * 256 + g * 64 + ch * 8); vq = *(const u32x4*)(KV + (size_t)row * 256 + 128 + g * 64 + ch * 8); }
        *(LAS u32x4*)(lds + ATT_KS + c * KS_STRIDE + ch * 16) = kq;
        LAS unsigned short* vt = (LAS unsigned short*)(lds + ATT_VT) + (ch * 8) * (VT_STRIDE / 2) + c;
        vt[0 * (VT_STRIDE / 2)] = (unsigned short)(vq.x & 0xffff); vt[1 * (VT_STRIDE / 2)] = (unsigned short)(vq.x >> 16);
        vt[2 * (VT_STRIDE / 2)] = (unsigned short)(vq.y & 0xffff); vt[3 * (VT_STRIDE / 2)] = (unsigned short)(vq.y >> 16);
        vt[4 * (VT_STRIDE / 2)] = (unsigned short)(vq.z & 0xffff); vt[5 * (VT_STRIDE / 2)] = (unsigned short)(vq.z >> 16);
        vt[6 * (VT_STRIDE / 2)] = (unsigned short)(vq.w & 0xffff); vt[7 * (VT_STRIDE / 2)] = (unsigned short)(vq.w >> 16);
    }
    __syncthreads();
    const int h = g * 8 + wid;
    const float sink2 = P.sinks[h] * LOG2E;
    for (int qt = 0; qt < 4; ++qt) {
        bf16_t* qrow = Q + (size_t)(rb + qt * 32 + qc) * 1024 + h * 64;
        bf16x8 qf[4];
#pragma unroll
        for (int s = 0; s < 4; ++s) qf[s] = *(const bf16x8*)(qrow + s * 16 + hi * 8);
        f32x16 sc[5];
#pragma unroll
        for (int jj = 0; jj < 5; ++jj) {
            sc[jj] = (f32x16){0.f};
            const LAS unsigned char* kp = lds + ATT_KS + (32 * (qt + jj) + qc) * KS_STRIDE + hi * 16;
#pragma unroll
            for (int s = 0; s < 4; ++s) { const bf16x8 kf = *(const LAS bf16x8*)(kp + s * 32); sc[jj] = __builtin_amdgcn_mfma_f32_32x32x16_bf16(kf, qf[s], sc[jj], 0, 0, 0); }
        }
        float mx = sink2;
#pragma unroll
        for (int jj = 0; jj < 5; ++jj)
#pragma unroll
            for (int r = 0; r < 16; ++r) {
                const int kr = crow(r, hi);
                bool ok = true;
                if (jj == 0) ok = kr >= qc + 1;
                if (jj == 4) ok = kr <= qc;
                if (qb == 0) ok = ok && (32 * (qt + jj) + kr >= 112);
                const float v = ok ? sc[jj][r] : -1e30f;
                sc[jj][r] = v; mx = fmaxf(mx, v);
            }
        { auto rr = __builtin_amdgcn_permlane32_swap(__float_as_uint(mx), __float_as_uint(mx), false, false); mx = fmaxf(__uint_as_float(rr[0]), __uint_as_float(rr[1])); }
        float l = 0.f;
#pragma unroll
        for (int jj = 0; jj < 5; ++jj)
#pragma unroll
            for (int r = 0; r < 16; ++r) { const float p = __builtin_amdgcn_exp2f(sc[jj][r] - mx); sc[jj][r] = p; l += p; }
        { auto rr = __builtin_amdgcn_permlane32_swap(__float_as_uint(l), __float_as_uint(l), false, false); l = __uint_as_float(rr[0]) + __uint_as_float(rr[1]); }
        l += __builtin_amdgcn_exp2f(sink2 - mx);
        const float rl = 1.f / l;
        f32x16 o[2]; o[0] = (f32x16){0.f}; o[1] = (f32x16){0.f};
#pragma unroll
        for (int jj = 0; jj < 5; ++jj)
#pragma unroll
            for (int t = 0; t < 2; ++t) {
                u32x4 pw; pw.x = cvt_pk_bf16(sc[jj][8 * t + 0], sc[jj][8 * t + 1]); pw.y = cvt_pk_bf16(sc[jj][8 * t + 2], sc[jj][8 * t + 3]);
                pw.z = cvt_pk_bf16(sc[jj][8 * t + 4], sc[jj][8 * t + 5]); pw.w = cvt_pk_bf16(sc[jj][8 * t + 6], sc[jj][8 * t + 7]);
                const bf16x8 pf = __builtin_bit_cast(bf16x8, pw);
#pragma unroll
                for (int dt = 0; dt < 2; ++dt) {
                    const LAS unsigned char* vp = lds + ATT_VT + (32 * dt + qc) * VT_STRIDE + (32 * (qt + jj) + 16 * t + 4 * hi) * 2;
                    const u32x2 lo = *(const LAS u32x2*)vp, hi2 = *(const LAS u32x2*)(vp + 16);
                    const u32x4 vw = (u32x4){lo.x, lo.y, hi2.x, hi2.y};
                    o[dt] = __builtin_amdgcn_mfma_f32_32x32x16_bf16(__builtin_bit_cast(bf16x8, vw), pf, o[dt], 0, 0, 0);
                }
            }
#pragma unroll
        for (int dt = 0; dt < 2; ++dt)
#pragma unroll
            for (int rq = 0; rq < 4; ++rq) {
                u32x2 w; w.x = cvt_pk_bf16(o[dt][4 * rq + 0] * rl, o[dt][4 * rq + 1] * rl); w.y = cvt_pk_bf16(o[dt][4 * rq + 2] * rl, o[dt][4 * rq + 3] * rl);
                *(u32x2*)(qrow + 32 * dt + 8 * rq + 4 * hi) = w;
            }
    }
}

constexpr int TC = 32;
constexpr int SC_W2 = 0, SC_A2 = 16384, SC_TW = 32768, SC_ZAL = 40960, SC_R = 49152, SC_W = 57344, SC_K = 65536, SC_A = 73728, SC_B = 81920, SC_V = 90112, SC_Y = 98304, SC_BON = 106496;
__device__ __forceinline__ void scan_item(const Params& P, LAS unsigned char* lds, int item) {
    const int tid = threadIdx.x, lane = tid & 63, wid = tid >> 6;
    const int b = item >> 4, h = item & 15, hj = h * 64 + lane;
    const bf16_t* RKV = (const bf16_t*)(P.ws + WS_RKV); const bf16_t* WA = (const bf16_t*)(P.ws + WS_WA); bf16_t* RW = (bf16_t*)(P.ws + WS_RW);
    LAS float* w2s = (LAS float*)(lds + SC_W2); LAS float* a2s = (LAS float*)(lds + SC_A2); LAS float* tw = (LAS float*)(lds + SC_TW); LAS float* zal = (LAS float*)(lds + SC_ZAL);
    LAS float* Rs = (LAS float*)(lds + SC_R); LAS float* Ws = (LAS float*)(lds + SC_W); LAS float* Ks = (LAS float*)(lds + SC_K); LAS float* As = (LAS float*)(lds + SC_A);
    LAS float* Bs = (LAS float*)(lds + SC_B); LAS float* Vs = (LAS float*)(lds + SC_V); LAS float* Ys = (LAS float*)(lds + SC_Y); LAS float* BON = (LAS float*)(lds + SC_BON);
    __syncthreads();
    for (int i = tid; i < 4096; i += 512) { const int r = i >> 6, c = i & 63; w2s[i] = P.w2[(size_t)r * 1024 + h * 64 + c]; a2s[i] = P.a2[(size_t)r * 1024 + h * 64 + c]; }
    const float mu_r = P.mu[hj], mu_k = P.mu[1024 + hj], mu_v = P.mu[2048 + hj], mu_wl = P.mu[3072 + lane], mu_al = P.mu[3136 + lane];
    const float w0v = P.w0[hj], a0v = P.a0[hj], kkv = P.k_k[hj], kav = P.k_a[hj], rkv = P.r_k[hj], lnw = P.ln_w[hj], lnb = P.ln_b[hj];
    float S[8];
#pragma unroll
    for (int c = 0; c < 8; ++c) S[c] = 0.f;
    const int srow = tid >> 3, scg = tid & 7;
    for (int t0 = 0; t0 < TT; t0 += TC) {
        const int nt = (TT - t0) < TC ? (TT - t0) : TC;
        float zr[4], zk[4], zv[4];
        {
            float pr = 0.f, pk = 0.f, pv = 0.f, pwl = 0.f, pal = 0.f;
            const int tp = t0 + 4 * wid - 1;
            if (tp >= 0 && tp < TT) { const size_t row = tp < NMETA ? (size_t)MREAL + tp : (size_t)b * SEQ + tp - NMETA;
                pr = bf2f(RKV[row * 3072 + hj]); pk = bf2f(RKV[row * 3072 + 1024 + hj]); pv = bf2f(RKV[row * 3072 + 2048 + hj]); pwl = bf2f(WA[row * 128 + lane]); pal = bf2f(WA[row * 128 + 64 + lane]); }
#pragma unroll
            for (int q = 0; q < 4; ++q) {
                const int tl = 4 * wid + q, tk = t0 + tl;
                float cr = 0.f, ck = 0.f, cv = 0.f, cwl = 0.f, cal = 0.f;
                if (tk < TT) { const size_t row = tk < NMETA ? (size_t)MREAL + tk : (size_t)b * SEQ + tk - NMETA;
                    cr = bf2f(RKV[row * 3072 + hj]); ck = bf2f(RKV[row * 3072 + 1024 + hj]); cv = bf2f(RKV[row * 3072 + 2048 + hj]); cwl = bf2f(WA[row * 128 + lane]); cal = bf2f(WA[row * 128 + 64 + lane]); }
                zr[q] = cr + (pr - cr) * mu_r; zk[q] = ck + (pk - ck) * mu_k; zv[q] = cv + (pv - cv) * mu_v;
                tw[tl * 64 + lane] = tanhf(cwl + (pwl - cwl) * mu_wl); zal[tl * 64 + lane] = cal + (pal - cal) * mu_al;
                pr = cr; pk = ck; pv = cv; pwl = cwl; pal = cal;
            }
        }
        __syncthreads();
        float aw[4], aa[4];
#pragma unroll
        for (int q = 0; q < 4; ++q) { aw[q] = w0v; aa[q] = a0v; }
        for (int i = 0; i < 64; ++i) {
            const float wv = w2s[i * 64 + lane], av = a2s[i * 64 + lane];
#pragma unroll
            for (int q = 0; q < 4; ++q) { aw[q] += tw[(4 * wid + q) * 64 + i] * wv; aa[q] += zal[(4 * wid + q) * 64 + i] * av; }
        }
#pragma unroll
        for (int q = 0; q < 4; ++q) {
            const int tl = 4 * wid + q;
            const float y = -aw[q];
            const float sp = fmaxf(y, 0.f) + log1pf(expf(-fabsf(y)));
            const float wlog = -sp - 0.5f;
            const float decay = expf(-expf(wlog));
            const float a = 1.f / (1.f + expf(-aa[q]));
            float kk = zk[q] * kkv;
            const float n2 = wave_sum(kk * kk);
            kk = kk / fmaxf(sqrtf(n2), 1e-12f);
            const float kp = zk[q] * (1.f + (a - 1.f) * kav);
            const float bon = wave_sum(zr[q] * kp * rkv);
            Rs[tl * 64 + lane] = zr[q]; Ws[tl * 64 + lane] = decay; Ks[tl * 64 + lane] = kp; As[tl * 64 + lane] = -kk; Bs[tl * 64 + lane] = kk * a; Vs[tl * 64 + lane] = zv[q];
            if (lane == 0) BON[tl] = bon;
        }
        __syncthreads();
        for (int t = 0; t < nt; ++t) {
            const f32x4 w_0 = *(const LAS f32x4*)(Ws + t * 64 + 8 * scg), w_1 = *(const LAS f32x4*)(Ws + t * 64 + 8 * scg + 4);
            const f32x4 a_0 = *(const LAS f32x4*)(As + t * 64 + 8 * scg), a_1 = *(const LAS f32x4*)(As + t * 64 + 8 * scg + 4);
            const f32x4 b_0 = *(const LAS f32x4*)(Bs + t * 64 + 8 * scg), b_1 = *(const LAS f32x4*)(Bs + t * 64 + 8 * scg + 4);
            const f32x4 k_0 = *(const LAS f32x4*)(Ks + t * 64 + 8 * scg), k_1 = *(const LAS f32x4*)(Ks + t * 64 + 8 * scg + 4);
            const f32x4 r_0 = *(const LAS f32x4*)(Rs + t * 64 + 8 * scg), r_1 = *(const LAS f32x4*)(Rs + t * 64 + 8 * scg + 4);
            const float v = Vs[t * 64 + srow];
            float sa = (S[0] * a_0[0] + S[1] * a_0[1]) + (S[2] * a_0[2] + S[3] * a_0[3]) + (S[4] * a_1[0] + S[5] * a_1[1]) + (S[6] * a_1[2] + S[7] * a_1[3]);
            sa = red8(sa);
#pragma unroll
            for (int c = 0; c < 4; ++c) { S[c] = S[c] * w_0[c] + sa * b_0[c] + v * k_0[c]; S[4 + c] = S[4 + c] * w_1[c] + sa * b_1[c] + v * k_1[c]; }
            float y = (S[0] * r_0[0] + S[1] * r_0[1]) + (S[2] * r_0[2] + S[3] * r_0[3]) + (S[4] * r_1[0] + S[5] * r_1[1]) + (S[6] * r_1[2] + S[7] * r_1[3]);
            y = red8(y);
            if (scg == 0) Ys[t * 64 + srow] = y;
        }
        __syncthreads();
#pragma unroll
        for (int q = 0; q < 4; ++q) {
            const int tl = 4 * wid + q, tk = t0 + tl;
            const float y = Ys[tl * 64 + lane];
            const float mean = wave_sum(y) * (1.f / 64.f);
            const float d = y - mean;
            const float var = wave_sum(d * d) * (1.f / 64.f);
            const float o = d * (1.f / sqrtf(var + GN_EPS)) * lnw + lnb + BON[tl] * Vs[tl * 64 + lane];
            if (tl < nt && tk >= NMETA) RW[((size_t)b * SEQ + tk - NMETA) * 1024 + hj] = f2bf(o);
        }
        __syncthreads();
    }
}

constexpr int CH = 16, NCHUNK = TT / CH;
constexpr int IMG_STRIDE = 144;
constexpr int SL_IMG_A = 0, SL_IMG_R = 2304, SL_IMG_B = 4608, SL_IMG_K = 6912, SL_IMG_V = 9216, SL_NAK = 11520, SL_TT = 12032, SL_MT = 12544, SL_GAM = 13568, SL_BON = 13824, SLOT_BYTES = 13888;
constexpr int SCR_STRIDE = 272;
constexpr int SL_SCR_W = 0, SL_SCR_A = 16 * SCR_STRIDE;
constexpr int NSLOT = 9;
constexpr int FL_FULL = 0, FL_CDONE = 48, FL_YDONE = 56;
constexpr int CS_W2IMG = NSLOT * SLOT_BYTES, CS_A2IMG = CS_W2IMG + 8192, CS_CONST = CS_A2IMG + 8192, CS_FLAGS = CS_CONST + 12 * 256, CS_YRING = CS_FLAGS + 64, YENT_BYTES = 16 * IMG_STRIDE, CS_END = CS_YRING + 8 * YENT_BYTES;
static_assert(CS_END <= LDS_BARST, "scan LDS map");
enum { CK_MU_R = 0, CK_MU_K, CK_MU_V, CK_MU_WL, CK_MU_AL, CK_W0, CK_A0, CK_KK, CK_KA, CK_RK, CK_LNW, CK_LNB };
typedef short v4i16 __attribute__((ext_vector_type(4)));
__device__ __forceinline__ u32x2 lds_tr16(const LAS unsigned char* p) { return __builtin_bit_cast(u32x2, __builtin_amdgcn_ds_read_tr16_b64_v4i16((LAS v4i16*)p)); }
__device__ __forceinline__ void lds_wait_ge(LAS unsigned char* p, int v) { while (*(volatile LAS int*)p < v) __builtin_amdgcn_s_sleep(1); asm volatile("" ::: "memory"); }
__device__ __forceinline__ void lds_flag_set(LAS unsigned char* p, int v, int lane) { asm volatile("s_waitcnt lgkmcnt(0)" ::: "memory"); if (lane == 0) *(volatile LAS int*)p = v; asm volatile("" ::: "memory"); }
__device__ __forceinline__ bf16x8 mk_frag(u32x2 lo, u32x2 hi) { return __builtin_bit_cast(bf16x8, (u32x4){lo.x, lo.y, hi.x, hi.y}); }
__device__ __forceinline__ u32x2 pk4(f32x4 v) { return (u32x2){cvt_pk_bf16(v[0], v[1]), cvt_pk_bf16(v[2], v[3])}; }
__device__ __forceinline__ void unpack8(u32x4 w, float* f) { f[0] = bflo(w.x); f[1] = bfhi(w.x); f[2] = bflo(w.y); f[3] = bfhi(w.y); f[4] = bflo(w.z); f[5] = bfhi(w.z); f[6] = bflo(w.w); f[7] = bfhi(w.w); }
__device__ __forceinline__ u32x4 pack8(const float* f) { return (u32x4){cvt_pk_bf16(f[0], f[1]), cvt_pk_bf16(f[2], f[3]), cvt_pk_bf16(f[4], f[5]), cvt_pk_bf16(f[6], f[7])}; }
__device__ __forceinline__ float red16(float v) {
    v += dppf<0xB1>(v); v += dppf<0x4E>(v); v += dppf<0x141>(v); v += dppf<0x140>(v); return v;
}
__device__ __forceinline__ float scan16(float v) {
    v += dppf<0x111>(v); v += dppf<0x112>(v); v += dppf<0x114>(v); v += dppf<0x118>(v); return v;
}
__device__ __forceinline__ float shr1_fill1(float v) {
    return __builtin_bit_cast(float, __builtin_amdgcn_update_dpp(0x3f800000, __builtin_bit_cast(int, v), 0x111, 0xF, 0xF, false));
}
#define MFMA32(a, b, c) __builtin_amdgcn_mfma_f32_16x16x32_bf16((a), (b), (c), 0, 0, 0)

__device__ __forceinline__ size_t scan_row(int b, int tau) { return tau < NMETA ? (size_t)MREAL + tau : (size_t)b * SEQ + (tau - NMETA); }

__device__ __forceinline__ void unpack4(u32x2 w, float* f) { f[0] = bflo(w.x); f[1] = bfhi(w.x); f[2] = bflo(w.y); f[3] = bfhi(w.y); }
__device__ __forceinline__ u32x2 pack4(const float* f) { return (u32x2){cvt_pk_bf16(f[0], f[1]), cvt_pk_bf16(f[2], f[3])}; }
__device__ __forceinline__ unsigned long long scan_producer(const Params& P, LAS unsigned char* lds, int b, int h, int pidx, int lane) {
    unsigned long long pticks = 0ull;
    const int t = lane & 15, g = lane >> 4;
    const bf16_t* RKV = (const bf16_t*)(P.ws + WS_RKV); const bf16_t* WA = (const bf16_t*)(P.ws + WS_WA);
    bf16_t* RW = (bf16_t*)(P.ws + WS_RW);
    const LAS unsigned char* cstg = lds + CS_CONST + 16 * g;
#define CROW(k, jt) (*(const LAS f32x4*)(cstg + ((k) * 256 + 64 * (jt))))
    const f32x4 fzero = (f32x4){0.f, 0.f, 0.f, 0.f};
    u32x2 raw_wa[2][2][4];
#define ISSUE_WA(cc) do { const int tau_ = 16 * (cc) + t; const size_t rc_ = scan_row(b, tau_), rp_ = scan_row(b, tau_ > 0 ? tau_ - 1 : 0); \
        _Pragma("unroll") for (int a_ = 0; a_ < 2; ++a_) _Pragma("unroll") for (int j_ = 0; j_ < 4; ++j_) { \
            raw_wa[a_][0][j_] = *(const u32x2*)(WA + rc_ * 128 + a_ * 64 + 16 * j_ + 4 * g); raw_wa[a_][1][j_] = *(const u32x2*)(WA + rp_ * 128 + a_ * 64 + 16 * j_ + 4 * g); } } while (0)
    u32x2 vprev[4] = {(u32x2){0u, 0u}, (u32x2){0u, 0u}, (u32x2){0u, 0u}, (u32x2){0u, 0u}}; float bon_prev = 0.f;
#define FINISH(cp) do { if ((cp) >= 1) { \
        unsigned long long fw0_ = 0ull; if (PROBE_PHASE == 28 || PROBE_PHASE == 29) fw0_ = __builtin_amdgcn_s_memrealtime(); \
        lds_wait_ge(lds + CS_FLAGS + FL_YDONE, (cp) + 1); lds_wait_ge(lds + CS_FLAGS + FL_YDONE + 4, (cp) + 1); \
        if (PROBE_PHASE == 28) pticks += __builtin_amdgcn_s_memrealtime() - fw0_; \
        const LAS unsigned char* yb_ = lds + CS_YRING + ((cp) & 7) * YENT_BYTES + t * IMG_STRIDE + 8 * g; \
        float y_[16], v_[16]; _Pragma("unroll") for (int j_ = 0; j_ < 4; ++j_) { unpack4(*(const LAS u32x2*)(yb_ + 32 * j_), y_ + 4 * j_); unpack4(vprev[j_], v_ + 4 * j_); } \
        float s1_ = 0.f; _Pragma("unroll") for (int i_ = 0; i_ < 16; ++i_) s1_ += y_[i_]; \
        s1_ += __shfl_xor(s1_, 16); s1_ += __shfl_xor(s1_, 32); const float mean_ = s1_ * (1.f / 64.f); \
        float s2_ = 0.f; _Pragma("unroll") for (int i_ = 0; i_ < 16; ++i_) { y_[i_] -= mean_; s2_ += y_[i_] * y_[i_]; } \
        s2_ += __shfl_xor(s2_, 16); s2_ += __shfl_xor(s2_, 32); const float rstd_ = __builtin_amdgcn_rsqf(s2_ * (1.f / 64.f) + GN_EPS); \
        bf16_t* orow_ = RW + ((size_t)b * SEQ + 16 * ((cp) - 1) + t) * 1024 + h * 64 + 4 * g; \
        _Pragma("unroll") for (int j_ = 0; j_ < 4; ++j_) { float o_[4]; const f32x4 w_ = CROW(CK_LNW, j_), b_ = CROW(CK_LNB, j_); \
            _Pragma("unroll") for (int e_ = 0; e_ < 4; ++e_) o_[e_] = y_[4 * j_ + e_] * rstd_ * w_[e_] + b_[e_] + bon_prev * v_[4 * j_ + e_]; \
            *(u32x2*)(orow_ + 16 * j_) = pack4(o_); } \
        if (PROBE_PHASE == 29) pticks += __builtin_amdgcn_s_memrealtime() - fw0_; } } while (0)
    ISSUE_WA(pidx);
    for (int k_ = 0; k_ < 2 * pidx; ++k_) __builtin_amdgcn_s_sleep(17);
    int clast = -1;
    unsigned long long sgt_ = 0ull;
#define SEG_START() do { if (PROBE_PHASE >= 23 && PROBE_PHASE < 28) sgt_ = __builtin_amdgcn_s_memrealtime(); } while (0)
#define SEG_END(k) do { if (PROBE_PHASE >= 23 && PROBE_PHASE < 28) { const unsigned long long n_ = __builtin_amdgcn_s_memrealtime(); if (PROBE_PHASE == (k)) pticks += n_ - sgt_; sgt_ = n_; } } while (0)
    for (int c = pidx; c < NCHUNK; c += 6) {
        LAS unsigned char* slot = lds + (c % NSLOT) * SLOT_BYTES;
        SEG_START();
        u32x2 raw_rkv[3][2][4];
        { const int tau_ = 16 * c + t; const size_t rc_ = scan_row(b, tau_), rp_ = scan_row(b, tau_ > 0 ? tau_ - 1 : 0);
#pragma unroll
          for (int a_ = 0; a_ < 3; ++a_)
#pragma unroll
            for (int j_ = 0; j_ < 4; ++j_) { raw_rkv[a_][0][j_] = *(const u32x2*)(RKV + rc_ * 3072 + a_ * 1024 + h * 64 + 16 * j_ + 4 * g); raw_rkv[a_][1][j_] = *(const u32x2*)(RKV + rp_ * 3072 + a_ * 1024 + h * 64 + 16 * j_ + 4 * g); } }
        if (c == 0 && t == 0) {
            const u32x2 zz2 = (u32x2){0u, 0u};
#pragma unroll
            for (int j_ = 0; j_ < 4; ++j_) { raw_rkv[0][1][j_] = zz2; raw_rkv[1][1][j_] = zz2; raw_rkv[2][1][j_] = zz2; raw_wa[0][1][j_] = zz2; raw_wa[1][1][j_] = zz2; }
        }
        bf16x8 twf[2], alf[2];
        { float tw[16], al[16];
#pragma unroll
          for (int j = 0; j < 4; ++j) { float cu[4], pr[4];
            const f32x4 m = CROW(CK_MU_WL, j), n = CROW(CK_MU_AL, j);
            unpack4(raw_wa[0][0][j], cu); unpack4(raw_wa[0][1][j], pr);
#pragma unroll
            for (int e = 0; e < 4; ++e) { const float zz = cu[e] + (pr[e] - cu[e]) * m[e]; const float ex = __builtin_amdgcn_exp2f(zz * (2.f * LOG2E)); tw[4 * j + e] = 1.f - 2.f * __builtin_amdgcn_rcpf(1.f + ex); }
            unpack4(raw_wa[1][0][j], cu); unpack4(raw_wa[1][1][j], pr);
#pragma unroll
            for (int e = 0; e < 4; ++e) al[4 * j + e] = cu[e] + (pr[e] - cu[e]) * n[e]; }
#pragma unroll
          for (int s = 0; s < 2; ++s) { twf[s] = __builtin_bit_cast(bf16x8, pack8(tw + 8 * s)); alf[s] = __builtin_bit_cast(bf16x8, pack8(al + 8 * s)); } }
        if (c + 6 < NCHUNK) ISSUE_WA(c + 6);
        float wr[16], ar[16];
#pragma unroll
        for (int j = 0; j < 4; ++j) { f32x4 aw = fzero, aa = fzero;
#pragma unroll
            for (int s = 0; s < 2; ++s) {
                aw = MFMA32(*(const LAS bf16x8*)(lds + CS_W2IMG + ((s * 4 + j) * 64 + lane) * 16), twf[s], aw);
                aa = MFMA32(*(const LAS bf16x8*)(lds + CS_A2IMG + ((s * 4 + j) * 64 + lane) * 16), alf[s], aa);
            }
#pragma unroll
            for (int r = 0; r < 4; ++r) { wr[4 * j + r] = aw[r]; ar[4 * j + r] = aa[r]; } }
        SEG_END(23);
        __builtin_amdgcn_sched_barrier(0);
        float zr[16], zk[16];
#pragma unroll
        for (int j = 0; j < 4; ++j) { float cu[4], pr[4];
            const f32x4 mr_ = CROW(CK_MU_R, j), mk_ = CROW(CK_MU_K, j);
            unpack4(raw_rkv[0][0][j], cu); unpack4(raw_rkv[0][1][j], pr);
#pragma unroll
            for (int e = 0; e < 4; ++e) zr[4 * j + e] = cu[e] + (pr[e] - cu[e]) * mr_[e];
            unpack4(raw_rkv[1][0][j], cu); unpack4(raw_rkv[1][1][j], pr);
#pragma unroll
            for (int e = 0; e < 4; ++e) zk[4 * j + e] = cu[e] + (pr[e] - cu[e]) * mk_[e]; }
        SEG_END(25);
        __builtin_amdgcn_sched_barrier(0);
        float ss = 0.f, bon = 0.f; float av[16];
#pragma unroll
        for (int j = 0; j < 4; ++j) {
            const f32x4 c_a0 = CROW(CK_A0, j), c_kk = CROW(CK_KK, j), c_ka = CROW(CK_KA, j), c_rk = CROW(CK_RK, j);
#pragma unroll
            for (int e = 0; e < 4; ++e) { const int i = 4 * j + e;
                const float a = sigmoidf_(c_a0[e] + ar[i]); av[i] = a;
                const float kr_ = zk[i] * c_kk[e]; ss += kr_ * kr_;
                bon += zr[i] * (zk[i] * (1.f + (a - 1.f) * c_ka[e])) * c_rk[e]; }
        }
        ss += __shfl_xor(ss, 16); ss += __shfl_xor(ss, 32); bon += __shfl_xor(bon, 16); bon += __shfl_xor(bon, 32);
        const float inv = 1.f / fmaxf(sqrtf(ss), 1e-12f);
        __builtin_amdgcn_sched_barrier(0);
        { unsigned long long pt0_ = 0ull; if (PROBE_PHASE == 22) pt0_ = __builtin_amdgcn_s_memrealtime();
          if (c >= NSLOT) { lds_wait_ge(lds + CS_FLAGS + FL_CDONE, c - NSLOT + 1); lds_wait_ge(lds + CS_FLAGS + FL_CDONE + 4, c - NSLOT + 1); }
          if (PROBE_PHASE == 22) pticks += __builtin_amdgcn_s_memrealtime() - pt0_; }
        u32x2 vnew[4];
#pragma unroll
        for (int j = 0; j < 4; ++j) { float cu[4], pr[4], z[4]; const f32x4 mv_ = CROW(CK_MU_V, j);
            unpack4(raw_rkv[2][0][j], cu); unpack4(raw_rkv[2][1][j], pr);
#pragma unroll
            for (int e = 0; e < 4; ++e) z[e] = cu[e] + (pr[e] - cu[e]) * mv_[e];
            vnew[j] = pack4(z); *(LAS u32x2*)(slot + SL_IMG_V + t * IMG_STRIDE + (16 * j + 4 * g) * 2) = vnew[j]; }
        if (g == 0) *(LAS float*)(slot + SL_BON + t * 4) = bon;
        __builtin_amdgcn_sched_barrier(0);
        u32x4 pA[2], pR[2], pB[2], pK[2];
#pragma unroll
        for (int s = 0; s < 2; ++s) {
            float fa[8], fr_[8], fb[8], fk[8];
#pragma unroll
            for (int q = 0; q < 2; ++q) {
                const int j = 2 * s + q; float gm_[4];
                const f32x4 c_w0 = CROW(CK_W0, j), c_kk = CROW(CK_KK, j), c_ka = CROW(CK_KA, j);
#pragma unroll
                for (int e = 0; e < 4; ++e) { const int i = 4 * j + e, k = 4 * q + e;
                    const float lw = -0.6065306597126334f * sigmoidf_(c_w0[e] + wr[i]);
                    const float L = scan16(lw);
                    const float eL = __builtin_amdgcn_exp2f(L * LOG2E), ieL = __builtin_amdgcn_rcpf(eL), eLm = shr1_fill1(eL);
                    const float kk = zk[i] * c_kk[e] * inv, kp = zk[i] * (1.f + (av[i] - 1.f) * c_ka[e]);
                    fa[k] = -kk * eLm; fb[k] = kk * av[i] * ieL; fk[k] = kp * ieL; fr_[k] = zr[i] * eL; gm_[e] = eL; }
                if (t == 15) *(LAS f32x4*)(slot + SL_GAM + (16 * j + 4 * g) * 4) = (f32x4){gm_[0], gm_[1], gm_[2], gm_[3]};
            }
            pA[s] = pack8(fa); pR[s] = pack8(fr_); pB[s] = pack8(fb); pK[s] = pack8(fk);
#pragma unroll
            for (int q = 0; q < 2; ++q) { const int off = t * IMG_STRIDE + (16 * (2 * s + q) + 4 * g) * 2;
                *(LAS u32x2*)(slot + SL_IMG_A + off) = q ? (u32x2){pA[s].z, pA[s].w} : (u32x2){pA[s].x, pA[s].y};
                *(LAS u32x2*)(slot + SL_IMG_R + off) = q ? (u32x2){pR[s].z, pR[s].w} : (u32x2){pR[s].x, pR[s].y};
                *(LAS u32x2*)(slot + SL_IMG_B + off) = q ? (u32x2){pB[s].z, pB[s].w} : (u32x2){pB[s].x, pB[s].y};
                *(LAS u32x2*)(slot + SL_IMG_K + off) = q ? (u32x2){pK[s].z, pK[s].w} : (u32x2){pK[s].x, pK[s].y}; }
            __builtin_amdgcn_sched_barrier(0);
        }
        SEG_END(26);
        bf16x8 Af[2], Rf[2], Bf[2], Kf[2];
#pragma unroll
        for (int s = 0; s < 2; ++s) { Af[s] = __builtin_bit_cast(bf16x8, pA[s]); Rf[s] = __builtin_bit_cast(bf16x8, pR[s]); Bf[s] = __builtin_bit_cast(bf16x8, pB[s]); Kf[s] = __builtin_bit_cast(bf16x8, pK[s]); }
        f32x4 nab = MFMA32(Bf[0], Af[0], fzero), nabT = MFMA32(Af[0], Bf[0], fzero), nak = MFMA32(Kf[0], Af[0], fzero), mbr = MFMA32(Bf[0], Rf[0], fzero), mkr = MFMA32(Kf[0], Rf[0], fzero);
        nab = MFMA32(Bf[1], Af[1], nab); nabT = MFMA32(Af[1], Bf[1], nabT); nak = MFMA32(Kf[1], Af[1], nak); mbr = MFMA32(Bf[1], Rf[1], mbr); mkr = MFMA32(Kf[1], Rf[1], mkr);
#pragma unroll
        for (int r = 0; r < 4; ++r) { const int s_ = 4 * g + r;
            if (!(s_ < t)) { nab[r] = 0.f; nak[r] = 0.f; }
            if (!(s_ <= t)) { mbr[r] = 0.f; mkr[r] = 0.f; }
            if (!(t < s_)) nabT[r] = 0.f; }
        const u32x2 z2 = (u32x2){0u, 0u};
#define FRG(x) mk_frag(pk4(x), z2)
        const bf16x8 fN = FRG(nab), fNT = FRG(nabT);
        const f32x4 n2 = MFMA32(fNT, fN, fzero), n2T = MFMA32(fN, fNT, fzero);
        const bf16x8 fN2 = FRG(n2), fN2T = FRG(n2T);
        const f32x4 n4 = MFMA32(fN2T, fN2, fzero), n4T = MFMA32(fN2, fN2T, fzero);
        const bf16x8 fN4 = FRG(n4), fN4T = FRG(n4T);
        const f32x4 n8T = MFMA32(fN4, fN4T, fzero);
        f32x4 q0 = nab;
#pragma unroll
        for (int r = 0; r < 4; ++r) if (4 * g + r == t) q0[r] += 1.f;
        const f32x4 q1 = MFMA32(fN2T, FRG(q0), q0);
        const f32x4 q2 = MFMA32(fN4T, FRG(q1), q1);
        const f32x4 tt = MFMA32(FRG(n8T), FRG(q2), q2);
#undef FRG
        *(LAS u32x2*)(slot + SL_NAK + lane * 8) = pk4(nak);
        *(LAS u32x2*)(slot + SL_TT + lane * 8) = pk4(tt);
        { const u32x2 a = pk4(mbr), bq = pk4(mkr); *(LAS u32x4*)(slot + SL_MT + lane * 16) = (u32x4){a.x, a.y, bq.x, bq.y}; }
        SEG_END(27);
        FINISH(clast);
#pragma unroll
        for (int j = 0; j < 4; ++j) vprev[j] = vnew[j];
        bon_prev = bon; clast = c;
        lds_flag_set(lds + CS_FLAGS + FL_FULL + 4 * (c % NSLOT), c + 1, lane);
        SEG_END(24);
    }
    FINISH(clast);
#undef FINISH
#undef ISSUE_WA
#undef CROW
#undef SEG_START
#undef SEG_END
    return pticks;
}

__device__ __forceinline__ unsigned long long scan_consumer(const Params& P, LAS unsigned char* lds, int b, int h, int wc, int lane) {
    unsigned long long pticks = 0ull;
#define PTICK_BEGIN(k) unsigned long long pt0_ = 0ull; if (PROBE_PHASE == (k)) pt0_ = __builtin_amdgcn_s_memrealtime()
#define PTICK_END(k) if (PROBE_PHASE == (k)) pticks += __builtin_amdgcn_s_memrealtime() - pt0_
    const int i16 = lane & 15, g = lane >> 4;
    const f32x4 fzero = (f32x4){0.f, 0.f, 0.f, 0.f};
    const u32x2 z2 = (u32x2){0u, 0u};
    f32x4 sacc[2][4];
#pragma unroll
    for (int n = 0; n < 2; ++n)
#pragma unroll
        for (int j = 0; j < 4; ++j) sacc[n][j] = fzero;
    __builtin_amdgcn_s_setprio(3);
    for (int c = 0; c < NCHUNK; ++c) {
        LAS unsigned char* slot = lds + (c % NSLOT) * SLOT_BYTES;
        { PTICK_BEGIN(20); lds_wait_ge(lds + CS_FLAGS + FL_FULL + 4 * (c % NSLOT), c + 1); PTICK_END(20); }
        bf16x8 Af[2], Rf[2];
#pragma unroll
        for (int s = 0; s < 2; ++s) {
            const int off = i16 * IMG_STRIDE + (32 * s + 4 * g) * 2;
            Af[s] = mk_frag(*(const LAS u32x2*)(slot + SL_IMG_A + off), *(const LAS u32x2*)(slot + SL_IMG_A + off + 32));
            Rf[s] = mk_frag(*(const LAS u32x2*)(slot + SL_IMG_R + off), *(const LAS u32x2*)(slot + SL_IMG_R + off + 32));
        }
        const u32x2 nak = *(const LAS u32x2*)(slot + SL_NAK + lane * 8), ttf = *(const LAS u32x2*)(slot + SL_TT + lane * 8);
        const bf16x8 MTf = *(const LAS bf16x8*)(slot + SL_MT + lane * 16);
        const int troff = (4 * g + (i16 >> 2)) * IMG_STRIDE + (i16 & 3) * 8;
        bf16x8 BKf[4];
#pragma unroll
        for (int jt = 0; jt < 4; ++jt) BKf[jt] = mk_frag(lds_tr16(slot + SL_IMG_B + troff + jt * 32), lds_tr16(slot + SL_IMG_K + troff + jt * 32));
        u32x2 vt[2];
#pragma unroll
        for (int n = 0; n < 2; ++n) vt[n] = lds_tr16(slot + SL_IMG_V + troff + (2 * wc + n) * 32);
        f32x4 gm[4];
#pragma unroll
        for (int jt = 0; jt < 4; ++jt) gm[jt] = *(const LAS f32x4*)(slot + SL_GAM + (16 * jt + 4 * g) * 4);
        lds_flag_set(lds + CS_FLAGS + FL_CDONE + 4 * wc, c + 1, lane);
        f32x4 yacc[2]; bf16x8 S0[2], S1[2], UV[2]; f32x4 x[2], u[2];
#pragma unroll
        for (int n = 0; n < 2; ++n) { S0[n] = mk_frag(pk4(sacc[n][0]), pk4(sacc[n][1])); S1[n] = mk_frag(pk4(sacc[n][2]), pk4(sacc[n][3])); }
#pragma unroll
        for (int n = 0; n < 2; ++n) x[n] = MFMA32(Af[0], S0[n], fzero);
#pragma unroll
        for (int n = 0; n < 2; ++n) x[n] = MFMA32(Af[1], S1[n], x[n]);
#pragma unroll
        for (int n = 0; n < 2; ++n) x[n] = MFMA32(mk_frag(z2, nak), mk_frag(z2, vt[n]), x[n]);
#pragma unroll
        for (int n = 0; n < 2; ++n) yacc[n] = MFMA32(Rf[0], S0[n], fzero);
#pragma unroll
        for (int n = 0; n < 2; ++n) yacc[n] = MFMA32(Rf[1], S1[n], yacc[n]);
#pragma unroll
        for (int n = 0; n < 2; ++n) u[n] = MFMA32(mk_frag(ttf, z2), mk_frag(pk4(x[n]), z2), fzero);
#pragma unroll
        for (int n = 0; n < 2; ++n) UV[n] = mk_frag(pk4(u[n]), vt[n]);
#pragma unroll
        for (int jt = 0; jt < 4; ++jt)
#pragma unroll
            for (int n = 0; n < 2; ++n) { const f32x4 sn = MFMA32(BKf[jt], UV[n], sacc[n][jt]); sacc[n][jt] = sn * gm[jt]; }
#pragma unroll
        for (int n = 0; n < 2; ++n) yacc[n] = MFMA32(MTf, UV[n], yacc[n]);
        { LAS unsigned char* yb = lds + CS_YRING + (c & 7) * YENT_BYTES;
#pragma unroll
          for (int n = 0; n < 2; ++n)
#pragma unroll
            for (int r = 0; r < 4; ++r) *(LAS unsigned short*)(yb + (4 * g + r) * IMG_STRIDE + (16 * (2 * wc + n) + i16) * 2) = f2bf(yacc[n][r]); }
        lds_flag_set(lds + CS_FLAGS + FL_YDONE + 4 * wc, c + 1, lane);
    }
    __builtin_amdgcn_s_setprio(0);
    return pticks;
#undef PTICK_BEGIN
#undef PTICK_END
}

__device__ __forceinline__ unsigned long long scan_item_chunked(const Params& P, LAS unsigned char* lds, int item) {
    int tid_ = threadIdx.x; asm volatile("" : "+v"(tid_));
    const int tid = tid_, lane = tid & 63, wid = __builtin_amdgcn_readfirstlane(tid >> 6);
    const int b = item >> 4, h = item & 15;
    __syncthreads();
    {
        const int fs = tid >> 8, fjt = (tid >> 6) & 3, l = tid & 63;
        float f[8], f2[8];
#pragma unroll
        for (int e = 0; e < 8; ++e) { const size_t idx = (size_t)(32 * fs + 16 * (e >> 2) + 4 * (l >> 4) + (e & 3)) * 1024 + h * 64 + 16 * fjt + (l & 15); f[e] = P.w2[idx]; f2[e] = P.a2[idx]; }
        *(LAS u32x4*)(lds + CS_W2IMG + tid * 16) = pack8(f); *(LAS u32x4*)(lds + CS_A2IMG + tid * 16) = pack8(f2);
    }
    if (tid < 64) {
        LAS float* cf = (LAS float*)(lds + CS_CONST); const int hj = h * 64 + tid;
        cf[CK_MU_R * 64 + tid] = P.mu[hj]; cf[CK_MU_K * 64 + tid] = P.mu[1024 + hj]; cf[CK_MU_V * 64 + tid] = P.mu[2048 + hj]; cf[CK_MU_WL * 64 + tid] = P.mu[3072 + tid]; cf[CK_MU_AL * 64 + tid] = P.mu[3136 + tid];
        cf[CK_W0 * 64 + tid] = P.w0[hj]; cf[CK_A0 * 64 + tid] = P.a0[hj]; cf[CK_KK * 64 + tid] = P.k_k[hj]; cf[CK_KA * 64 + tid] = P.k_a[hj]; cf[CK_RK * 64 + tid] = P.r_k[hj];
        cf[CK_LNW * 64 + tid] = P.ln_w[hj]; cf[CK_LNB * 64 + tid] = P.ln_b[hj];
        if (tid < 16) *(LAS int*)(lds + CS_FLAGS + 4 * tid) = 0;
    }
    __syncthreads();
    unsigned long long pticks = 0ull;
    if (wid < 2) pticks = scan_consumer(P, lds, b, h, wid, lane);
    else pticks = scan_producer(P, lds, b, h, wid - 2, lane);
    if (PROBE_PHASE >= 22 && PROBE_PHASE < 30) { if (tid == 128) *(LAS unsigned long long*)(lds + CS_END) = pticks; }
    __syncthreads();
    if (PROBE_PHASE >= 22 && PROBE_PHASE < 30) pticks = *(LAS unsigned long long*)(lds + CS_END);
    return pticks;
}

#define XB_TMO      128
#define XB_XCNT(j)  (256  + 64 * (j))
#define XB_XSUB(j)  (1280 + 64 * (j))
#define XB_XGEN(j)  (2304 + 64 * (j))
#define XB_TOP      3328
#define XB_TOPGEN   3392
#define XCD_BAR_WORDS 3456
#define XB_SPIN_CAP (1u << 18)
__device__ __forceinline__ unsigned xb_ld(unsigned* p)              { return __hip_atomic_load(p, __ATOMIC_RELAXED, __HIP_MEMORY_SCOPE_AGENT); }
__device__ __forceinline__ unsigned xb_add(unsigned* p, unsigned v) { return __hip_atomic_fetch_add(p, v, __ATOMIC_RELAXED, __HIP_MEMORY_SCOPE_AGENT); }
__device__ __forceinline__ unsigned xb_xcc_id() { return (unsigned)__builtin_amdgcn_s_getreg((3 << 11) | 20) & 0xFu; }
#define XB_SPIN(cond, bar) do { unsigned _sp = 0; while (cond) { __builtin_amdgcn_s_sleep(1); \
    if ((++_sp & 255u) == 0u) { if (xb_ld(&(bar)[XB_TMO])) break; if (_sp > XB_SPIN_CAP) { atomicAdd(&(bar)[XB_TMO], 1u); break; } } } } while (0)
struct XcdBarrier { unsigned* bar; unsigned x; volatile LAS unsigned* st; };
__device__ __forceinline__ XcdBarrier xcd_barrier_post(unsigned* bar, volatile LAS unsigned* st) {
    XcdBarrier b; b.bar = bar; b.x = xb_xcc_id(); b.st = st;
    if (threadIdx.x == 0) (void)xb_add(&bar[XB_XCNT(b.x)], 1u);
    return b;
}
__device__ __forceinline__ void xcd_barrier_complete(unsigned* bar, unsigned x, unsigned& nloc, unsigned& nx) {
    const unsigned G = gridDim.x * gridDim.y * gridDim.z;
    unsigned sum, cnt, mine, sp = 0u;
    for (;;) {
        sum = 0u; cnt = 0u; mine = 0u;
#pragma unroll
        for (unsigned j = 0; j < 16; ++j) { const unsigned c = xb_ld(&bar[XB_XCNT(j)]); sum += c; cnt += (c > 0u) ? 1u : 0u; mine = (j == x) ? c : mine; }
        if (sum == G) break;
        __builtin_amdgcn_s_sleep(1);
        if ((++sp & 255u) == 0u) { if (xb_ld(&bar[XB_TMO])) break; if (sp > XB_SPIN_CAP) { atomicAdd(&bar[XB_TMO], 1u); break; } }
    }
    nloc = mine > 0u ? mine : 1u; nx = cnt > 0u ? cnt : 1u;
}
__device__ __forceinline__ void xcd_barrier(const XcdBarrier& b) {
    asm volatile("s_waitcnt vmcnt(0)" ::: "memory");
    __syncthreads();
    if (threadIdx.x == 0) {
        unsigned* bar = b.bar;
        __builtin_amdgcn_s_waitcnt(0);
        unsigned nloc = b.st[0], nx = b.st[1];
        if (nloc == 0u) { xcd_barrier_complete(bar, b.x, nloc, nx); b.st[0] = nloc; b.st[1] = nx; }
        const unsigned old = xb_add(&bar[XB_XSUB(b.x)], 1u);
        const unsigned gen = old / nloc;
        if (old + 1u == (gen + 1u) * nloc) {
            __builtin_amdgcn_fence(__ATOMIC_RELEASE, "agent");
            asm volatile("s_waitcnt vmcnt(0)" ::: "memory");
            const unsigned og = xb_add(&bar[XB_TOP], 1u);
            const unsigned tg = og / nx;
            if (og + 1u == (tg + 1u) * nx) xb_add(&bar[XB_TOPGEN], 1u);
            else XB_SPIN(xb_ld(&bar[XB_TOPGEN]) == tg, bar);
            __builtin_amdgcn_fence(__ATOMIC_ACQUIRE, "agent");
            xb_add(&bar[XB_XGEN(b.x)], 1u);
            asm volatile("s_waitcnt vmcnt(0)" ::: "memory");
        } else {
            XB_SPIN(xb_ld(&bar[XB_XGEN(b.x)]) == gen, bar);
            __builtin_amdgcn_fence(__ATOMIC_ACQUIRE, "agent");
            asm volatile("s_waitcnt vmcnt(0)" ::: "memory");
        }
    }
    __syncthreads();
}

__device__ __forceinline__ void final_norm(const Params& P, int G) {
    int tid_ = threadIdx.x; asm volatile("" : "+v"(tid_));
    const int lane = tid_ & 63, gw = blockIdx.x * 8 + (tid_ >> 6), NGW = G * 8;
    const float* rowss = (const float*)(P.ws + WS_ROWSS);
    const f32x4* fw = (const f32x4*)P.fnw + lane;
    const f32x4 w0 = fw[0], w1 = fw[64], w2 = fw[128], w3 = fw[192];
    for (int r0 = gw * 2; r0 < MREAL; r0 += NGW * 2) {
        f32x4 v[2][4]; float rs[2];
#pragma unroll
        for (int k = 0; k < 2; ++k) { f32x4* o = (f32x4*)(P.out + (size_t)(r0 + k) * 1024) + lane; rs[k] = rowss[r0 + k];
#pragma unroll
            for (int j = 0; j < 4; ++j) v[k][j] = o[64 * j]; }
#pragma unroll
        for (int k = 0; k < 2; ++k) { f32x4* o = (f32x4*)(P.out + (size_t)(r0 + k) * 1024) + lane; const float rstd = __builtin_amdgcn_rsqf(rs[k] * (1.f / DM) + RMS_EPS);
            o[0] = v[k][0] * rstd * w0; o[64] = v[k][1] * rstd * w1; o[128] = v[k][2] * rstd * w2; o[192] = v[k][3] * rstd * w3; }
    }
}

__global__ void __launch_bounds__(512, 2) fwd_megakernel(Params P) {
    extern __shared__ __attribute__((aligned(16))) unsigned char lds_raw[];
    LAS unsigned char* lds = (LAS unsigned char*)lds_raw;
    cg::grid_group grid = cg::this_grid();
    const int G = gridDim.x;
    if (threadIdx.x < 16) ((LAS unsigned*)(lds + LDS_BARST))[threadIdx.x] = 0u;
    __syncthreads();
    const XcdBarrier bar = xcd_barrier_post((unsigned*)(P.ws + WS_CTL), (volatile LAS unsigned*)(lds + LDS_BARST));
    unsigned long long probe_wait = 0ull, probe_t0 = 0ull;
    const unsigned long long probe_k0 = (PROBE_PHASE == 8) ? __builtin_amdgcn_s_memrealtime() : 0ull;
#define PROBE_BEGIN(k) do { if (PROBE_PHASE == (k)) probe_t0 = __builtin_amdgcn_s_memrealtime(); } while (0)
#define PROBE_END(k) do { if (PROBE_PHASE == (k)) probe_wait += __builtin_amdgcn_s_memrealtime() - probe_t0; } while (0)
#define XBAR() do { PROBE_BEGIN(7); xcd_barrier(bar); PROBE_END(7); } while (0)
    bf16_t* U = (bf16_t*)(P.ws + WS_U); bf16_t* Q = (bf16_t*)(P.ws + WS_Q); bf16_t* RW = (bf16_t*)(P.ws + WS_RW);
    const bf16_t* WinT = (const bf16_t*)(P.ws + WS_WIN); const bf16_t* WbT = (const bf16_t*)(P.ws + WS_WB); const bf16_t* WoT = (const bf16_t*)(P.ws + WS_WOUT);
    bf16_t* SG = (bf16_t*)P.out;
    constexpr int NG_P2 = 1792;
    PROBE_BEGIN(0);
    if (PHASE_MASK & 1) p0_prologue(P, lds, G);
    PROBE_END(0);
    if (gridDim.y != 1) { __builtin_amdgcn_fence(__ATOMIC_SEQ_CST, "agent"); grid.sync(); __builtin_amdgcn_fence(__ATOMIC_SEQ_CST, "agent"); }
    XBAR();
    PROBE_BEGIN(1);
    if (PHASE_MASK & 2) {
        if (threadIdx.x < 64) for (int tl = blockIdx.x; tl < 4480 / 16; tl += G) p1_meta_tile(P, tl, threadIdx.x);
        pg8::Gemm g{U, U, WinT, 1024, 1 << 30};
        pg8::StaticOrder S; S.init(MREAL, NP1, G, (int)blockIdx.x);
        EpiP1 E{Q, (bf16_t*)(P.ws + WS_KV), (bf16_t*)(P.ws + WS_RKV), (bf16_t*)(P.ws + WS_WA), (const float*)(P.ws + WS_ROPE)};
        pg8::gemm_phase<EpiP1, pg8::StaticOrder, true>(lds, g, S, E);
    }
    PROBE_END(1);
    XBAR();
    PROBE_BEGIN(2);
    if (G == 256) {
        if (blockIdx.x < 128) { if (PHASE_MASK & 4) { const unsigned long long pt_ = scan_item_chunked(P, lds, blockIdx.x); if (PROBE_PHASE >= 20 && PROBE_PHASE < 30) probe_wait += pt_; } }
        else {
            if (PHASE_MASK & 8) for (int u = blockIdx.x - 128; u < 1024; u += 128) attn_unit(P, lds, u);
            __syncthreads();
            if (PHASE_MASK & 0x10) {
                pg8::Gemm g{U, U, WinT + (size_t)(NP1 + 2048) * 1024, 1024, 1 << 30};
                pg8::StaticOrder S; S.init(MREAL, 2048, 128, (int)blockIdx.x - 128); S.range(0, NG_P2);
                EpiGate E{Q, RW, SG, 8};
                pg8::gemm_phase<EpiGate, pg8::StaticOrder, true>(lds, g, S, E);
            }
        }
    } else {
        for (int it = blockIdx.x; it < 128 + 1024; it += G) { if (it < 128) { if (PHASE_MASK & 4) scan_item_chunked(P, lds, it); } else { if (PHASE_MASK & 8) attn_unit(P, lds, it - 128); } }
    }
    PROBE_END(2);
    XBAR();
    PROBE_BEGIN(3);
    if (PHASE_MASK & 0x10) {
        {
            pg8::Gemm g{U, U, WinT + (size_t)(NP1 + 2048) * 1024, 1024, 1 << 30};
            pg8::StaticOrder S; S.init(MREAL, 2048, G, (int)blockIdx.x); S.range(G == 256 ? NG_P2 : 0, 2048);
            EpiGate E{Q, RW, SG, 8};
            pg8::gemm_phase<EpiGate, pg8::StaticOrder, true>(lds, g, S, E);
        }
        {
            pg8::Gemm g{U, U, WinT + (size_t)NP1 * 1024, 1024, 1 << 30};
            pg8::StaticOrder S; S.init(MREAL, 2048, G, (int)blockIdx.x);
            EpiGate E{Q, RW, SG, 0};
            pg8::gemm_phase<EpiGate, pg8::StaticOrder, true>(lds, g, S, E);
        }
    }
    PROBE_END(3);
    XBAR();
    PROBE_BEGIN(4);
    if (PHASE_MASK & 0x20) {
        pg8::Gemm g{Q, Q, WbT, 1024, 1 << 30};
        pg8::StaticOrder S; S.init(MREAL, 1024, G, (int)blockIdx.x);
        EpiBranch E{U, SG, 0};
        pg8::gemm_phase<EpiBranch, pg8::StaticOrder, true>(lds, g, S, E);
    }
    XBAR();
    if (PHASE_MASK & 0x20) {
        pg8::Gemm g{RW, RW, WbT + (size_t)1024 * 1024, 1024, 1 << 30};
        pg8::StaticOrder S; S.init(MREAL, 1024, G, (int)blockIdx.x);
        EpiBranch E{U, SG, 4};
        pg8::gemm_phase<EpiBranch, pg8::StaticOrder, true>(lds, g, S, E);
    }
    PROBE_END(4);
    XBAR();
    PROBE_BEGIN(5);
    if (PHASE_MASK & 0x40) {
        pg8::Gemm g{U, U, WoT, 1024, 1 << 30};
        pg8::StaticOrder S; S.init(MREAL, 1024, G, (int)blockIdx.x);
        EpiOut E{P.x, P.out, (float*)(P.ws + WS_ROWSS)};
        pg8::gemm_phase<EpiOut, pg8::StaticOrder, true>(lds, g, S, E);
    }
    PROBE_END(5);
    XBAR();
    PROBE_BEGIN(6);
    if (PHASE_MASK & 0x80) final_norm(P, G);
    PROBE_END(6);
    if (PROBE_PHASE == 8) probe_wait = __builtin_amdgcn_s_memrealtime() - probe_k0;
    if (PROBE_PHASE >= 0 && blockIdx.x == PROBE_BLOCK && threadIdx.x == 0) {
        const unsigned long long t = __builtin_amdgcn_s_memrealtime();
        while (__builtin_amdgcn_s_memrealtime() - t < probe_wait) __builtin_amdgcn_s_sleep(8);
    }
}

extern "C" void kernel_launch(void* const* d_in, const int* in_sizes, int n_in, void* d_out, int out_size, void* d_ws, size_t ws_size, hipStream_t stream) {
    static int grid = 0;
    if (grid == 0) {
        if (n_in != 19 || in_sizes[0] != MREAL * DM || out_size != MREAL * DM || ws_size < WS_END) {
            fprintf(stderr, "kernel_launch: unexpected shapes (n_in %d, in0 %d, out %d, ws %zu); nothing launched\n", n_in, n_in > 0 ? in_sizes[0] : -1, out_size, ws_size); grid = -1; return; }
        int dev = 0, cus = 0, per_cu = 0;
        hipGetDevice(&dev);
        hipDeviceGetAttribute(&cus, hipDeviceAttributeMultiprocessorCount, dev);
        hipFuncSetAttribute((const void*)fwd_megakernel, hipFuncAttributeMaxDynamicSharedMemorySize, LDS_BYTES);
        hipOccupancyMaxActiveBlocksPerMultiprocessor(&per_cu, (const void*)fwd_megakernel, 512, LDS_BYTES);
        if (per_cu < 1) { fprintf(stderr, "kernel_launch: occupancy query says %d blocks per CU\n", per_cu); per_cu = 1; }
        grid = cus * 1;
        if (grid > 256) grid = 256;
        (void)hipGetLastError();
    }
    if (grid < 0) return;
    if (hipMemsetAsync((char*)d_ws + WS_CTL, 0, CTL_ZERO_BYTES, stream) != hipSuccess) { fprintf(stderr, "kernel_launch: hipMemsetAsync failed\n"); return; }
    Params p{};
    p.x = (const float*)d_in[0]; p.meta = (const float*)d_in[1]; p.norm_w = (const float*)d_in[2]; p.w_in = (const float*)d_in[3]; p.sinks = (const float*)d_in[4];
    p.mu = (const float*)d_in[5]; p.w0 = (const float*)d_in[6]; p.w2 = (const float*)d_in[7]; p.a0 = (const float*)d_in[8]; p.a2 = (const float*)d_in[9];
    p.k_k = (const float*)d_in[10]; p.k_a = (const float*)d_in[11]; p.r_k = (const float*)d_in[12]; p.ln_w = (const float*)d_in[13]; p.ln_b = (const float*)d_in[14];
    p.w_ba = (const float*)d_in[15]; p.w_br = (const float*)d_in[16]; p.w_out = (const float*)d_in[17]; p.fnw = (const float*)d_in[18];
    p.out = (float*)d_out; p.ws = (unsigned char*)d_ws;
    void* args[] = {&p};
    hipError_t e = hipLaunchCooperativeKernel((const void*)fwd_megakernel, dim3(grid), dim3(512), args, LDS_BYTES, stream);
    if (e != hipSuccess) fprintf(stderr, "cooperative launch failed: %s (grid %d)\n", hipGetErrorString(e), grid);
}
```
